# Optimizing an MI355X kernel written in HIP

```python
import math
import jax, jax.numpy as jnp
from jax import lax
import numpy as np

D_MODEL = 1024
BATCH = 16
SEQ = 4096
DEPTH = 4

N_MIXERS = 2
N_LRU = (DEPTH + 1) // 2
N_RET = DEPTH // 2

D_RNN = 3 * D_MODEL // 2
N_GATE_BLOCKS = 16
BLOCK_W = D_RNN // N_GATE_BLOCKS
CONV_W = 4
C_RG = 8.0

RET_HEADS = D_MODEL // 256
QK_HEAD = 256
V_HEAD = 2 * QK_HEAD
QK_DIM = RET_HEADS * QK_HEAD
V_DIM = RET_HEADS * V_HEAD
CHUNK = 128
ROPE_BASE = 10000.0

RMS_EPS = 1e-6
GN_EPS = 1e-5

kernel_name = "hybrid_rglru_retention_sandwich"


def rms_norm(x, g):
    xf = x.astype(jnp.float32)
    y = xf * lax.rsqrt(jnp.mean(xf * xf, axis=-1, keepdims=True) + RMS_EPS)
    return (y * g.astype(jnp.float32)).astype(x.dtype)


def causal_depthwise_conv(x, w, b):
    s = x.shape[1]
    xp = jnp.pad(x, ((0, 0), (CONV_W - 1, 0), (0, 0)))
    y = b
    for k in range(CONV_W):
        y = y + xp[:, k:k + s] * w[k]
    return y


def _lin_rec_combine(e1, e2):
    a1, b1 = e1
    a2, b2 = e2
    return a1 * a2, a2 * b1 + b2


def rglru_mixer(h, w_in, conv_w, conv_b, w_a, b_a, w_x, b_x, lam, w_out):
    bsz, s, _ = h.shape
    u = h @ w_in
    xb, gate = u[..., :D_RNN], u[..., D_RNN:]
    xb = causal_depthwise_conv(xb, conv_w, conv_b)
    xblk = xb.reshape(bsz, s, N_GATE_BLOCKS, BLOCK_W)
    r = jax.nn.sigmoid(jnp.einsum('bsnc,ncd->bsnd', xblk, w_a).reshape(bsz, s, D_RNN) + b_a)
    i = jax.nn.sigmoid(jnp.einsum('bsnc,ncd->bsnd', xblk, w_x).reshape(bsz, s, D_RNN) + b_x)
    log_a = -C_RG * r.astype(jnp.float32) * jax.nn.softplus(-lam.astype(jnp.float32))
    a = jnp.exp(log_a)
    bt = jnp.sqrt(-jnp.expm1(2.0 * log_a)) * (i * xb).astype(jnp.float32)
    _, hseq = lax.associative_scan(_lin_rec_combine, (a, bt), axis=1)
    y = hseq.astype(h.dtype) * jax.nn.silu(gate)
    return y @ w_out


def apply_rotary(x, cos, sin):
    half = x.shape[-1] // 2
    x1, x2 = x[..., :half], x[..., half:]
    c = cos[None, :, None, :]
    s_ = sin[None, :, None, :]
    return jnp.concatenate([x1 * c - x2 * s_, x2 * c + x1 * s_], axis=-1)


def retention_mixer(h, w_in, w_out, cos, sin):
    bsz, s, _ = h.shape
    n_chunks = s // CHUNK
    u = h @ w_in
    q = u[..., :QK_DIM].reshape(bsz, s, RET_HEADS, QK_HEAD).astype(jnp.float32)
    k = u[..., QK_DIM:2 * QK_DIM].reshape(bsz, s, RET_HEADS, QK_HEAD).astype(jnp.float32)
    v = u[..., 2 * QK_DIM:2 * QK_DIM + V_DIM].reshape(bsz, s, RET_HEADS, V_HEAD).astype(jnp.float32)
    gate = u[..., 2 * QK_DIM + V_DIM:]
    q = apply_rotary(q, cos, sin)
    k = apply_rotary(k, cos, sin) * (QK_HEAD ** -0.5)

    def to_chunks(t):
        return t.reshape(bsz, n_chunks, CHUNK, RET_HEADS, t.shape[-1]).transpose(1, 0, 3, 2, 4)

    qc, kc, vc = to_chunks(q), to_chunks(k), to_chunks(v)

    log_g = jnp.log(1.0 - jnp.exp2(-5.0 - jnp.arange(RET_HEADS, dtype=jnp.float32)))
    idx = jnp.arange(CHUNK, dtype=jnp.float32)
    diff = idx[:, None] - idx[None, :]
    dmask = jnp.where(diff[None] >= 0, jnp.exp(jnp.maximum(diff, 0.0)[None] * log_g[:, None, None]), 0.0)
    q_decay = jnp.exp((idx[None, :] + 1.0) * log_g[:, None])[..., None]
    k_decay = jnp.exp((CHUNK - 1.0 - idx[None, :]) * log_g[:, None])[..., None]
    chunk_decay = jnp.exp(CHUNK * log_g)[:, None, None]

    def step(state, inp):
        qi, ki, vi = inp
        scores = jnp.einsum('bhqd,bhkd->bhqk', qi, ki) * dmask
        inner = jnp.einsum('bhqk,bhke->bhqe', scores, vi)
        cross = jnp.einsum('bhqd,bhde->bhqe', qi * q_decay, state)
        new_state = state * chunk_decay + jnp.einsum('bhkd,bhke->bhde', ki * k_decay, vi)
        return new_state, inner + cross

    state0 = jnp.zeros((bsz, RET_HEADS, QK_HEAD, V_HEAD), jnp.float32)
    _, out = lax.scan(step, state0, (qc, kc, vc))
    out = out.transpose(1, 0, 3, 2, 4).reshape(bsz, s, RET_HEADS, V_HEAD)
    mu = jnp.mean(out, axis=-1, keepdims=True)
    var = jnp.mean(jnp.square(out - mu), axis=-1, keepdims=True)
    out = ((out - mu) * lax.rsqrt(var + GN_EPS)).reshape(bsz, s, V_DIM).astype(h.dtype)
    y = out * jax.nn.silu(gate)
    return y @ w_out


def setup_inputs(seed: int = 0) -> dict:
    key = jax.random.key(seed)
    ks = jax.random.split(key, 16)
    f32 = jnp.float32

    def nrm(k, shape, fan_in):
        return jax.random.normal(k, shape, f32) * (fan_in ** -0.5)

    x = jax.random.normal(ks[0], (BATCH, SEQ, D_MODEL), f32)
    norm_pre = 1.0 + 0.05 * jax.random.normal(ks[1], (DEPTH, D_MODEL), f32)
    norm_post = 1.0 + 0.05 * jax.random.normal(ks[2], (DEPTH, D_MODEL), f32)
    lru_w_in = nrm(ks[3], (N_LRU, D_MODEL, 2 * D_RNN), D_MODEL)
    lru_conv_w = nrm(ks[4], (N_LRU, CONV_W, D_RNN), CONV_W)
    lru_conv_b = 0.02 * jax.random.normal(ks[5], (N_LRU, D_RNN), f32)
    lru_w_a = nrm(ks[6], (N_LRU, N_GATE_BLOCKS, BLOCK_W, BLOCK_W), BLOCK_W)
    lru_b_a = 0.02 * jax.random.normal(ks[7], (N_LRU, D_RNN), f32)
    lru_w_x = nrm(ks[8], (N_LRU, N_GATE_BLOCKS, BLOCK_W, BLOCK_W), BLOCK_W)
    lru_b_x = 0.02 * jax.random.normal(ks[9], (N_LRU, D_RNN), f32)
    a_c = jax.random.uniform(ks[10], (N_LRU, D_RNN), f32, minval=0.9, maxval=0.999)
    sig = a_c ** (1.0 / C_RG)
    lru_lambda = jnp.log(sig) - jnp.log1p(-sig)
    lru_w_out = nrm(ks[11], (N_LRU, D_RNN, D_MODEL), D_RNN)
    ret_w_in = nrm(ks[12], (N_RET, D_MODEL, 2 * QK_DIM + 2 * V_DIM), D_MODEL)
    ret_w_out = nrm(ks[13], (N_RET, V_DIM, D_MODEL), V_DIM)
    return {"x": x, "norm_pre": norm_pre, "norm_post": norm_post,
            "lru_w_in": lru_w_in, "lru_conv_w": lru_conv_w, "lru_conv_b": lru_conv_b,
            "lru_w_a": lru_w_a, "lru_b_a": lru_b_a, "lru_w_x": lru_w_x, "lru_b_x": lru_b_x,
            "lru_lambda": lru_lambda, "lru_w_out": lru_w_out,
            "ret_w_in": ret_w_in, "ret_w_out": ret_w_out}


def reference(x, norm_pre, norm_post, lru_w_in, lru_conv_w, lru_conv_b, lru_w_a, lru_b_a,
              lru_w_x, lru_b_x, lru_lambda, lru_w_out, ret_w_in, ret_w_out):
    s = x.shape[1]
    pos = jnp.arange(s, dtype=jnp.float32)
    inv_freq = ROPE_BASE ** (-jnp.arange(0, QK_HEAD, 2, dtype=jnp.float32) / QK_HEAD)
    ang = pos[:, None] * inv_freq[None, :]
    cos, sin = jnp.cos(ang), jnp.sin(ang)
    for layer in range(DEPTH):
        h = rms_norm(x, norm_pre[layer])
        j = layer // N_MIXERS
        if layer % N_MIXERS == 0:
            o = rglru_mixer(h, lru_w_in[j], lru_conv_w[j], lru_conv_b[j], lru_w_a[j], lru_b_a[j],
                            lru_w_x[j], lru_b_x[j], lru_lambda[j], lru_w_out[j])
        else:
            o = retention_mixer(h, ret_w_in[j], ret_w_out[j], cos, sin)
        x = x + rms_norm(o, norm_post[layer])
    return x
```

```cpp
#include <hip/hip_runtime.h>
#include <cstdio>
#include <cstdint>

#ifndef MK_SPLIT
#define MK_SPLIT 0
#endif
#ifndef PH_MASK
#define PH_MASK 0x1ff
#endif
#define EN(b) ((PH_MASK >> (b)) & 1)
#ifndef RET_ABL
#define RET_ABL 0
#endif
#ifndef LRU_ABL
#define LRU_ABL 0
#endif
#ifndef PGA
#define PGA false
#endif
#ifndef PROBE_DUP
#define PROBE_DUP 0
#endif

#define LAS __attribute__((address_space(3)))
#define GAS __attribute__((address_space(1)))
typedef unsigned short bf16;
typedef short bf16x8 __attribute__((ext_vector_type(8)));
typedef short s16x4 __attribute__((ext_vector_type(4)));
typedef float f32x4 __attribute__((ext_vector_type(4)));
typedef float f32x2 __attribute__((ext_vector_type(2)));
typedef unsigned u32x4 __attribute__((ext_vector_type(4)));
typedef unsigned u32x2 __attribute__((ext_vector_type(2)));
typedef __bf16 bf16x2_t __attribute__((ext_vector_type(2)));

constexpr int BATCH = 16, SEQ = 4096, DM = 1024, M = BATCH * SEQ;
constexpr int DRNN = 1536, NGB = 16, BW = 96, NLRU = 2 * DRNN;
constexpr int RH = 4, QKH = 256, VH = 512, QKD = 1024, VD = 2048, NRET = 2 * QKD + 2 * VD;
constexpr float RMS_EPS = 1e-6f, GN_EPS = 1e-5f;
constexpr float LOG2E = 1.4426950408889634f;

constexpr size_t MiB = 1u << 20;
constexpr size_t WS_CTL = 0, CTL_ZERO_BYTES = 2 * MiB;
constexpr size_t WS_GRAN = 1 * MiB;
constexpr size_t WS_WLIN = 2 * MiB;
constexpr size_t WS_WLOUT = 14 * MiB;
constexpr size_t WS_WRIN = 20 * MiB;
constexpr size_t WS_WROUT = 44 * MiB;
constexpr size_t WS_GATEW = 52 * MiB;
constexpr size_t WS_ROPE = 54 * MiB;
constexpr size_t WS_STATS = 58 * MiB;
constexpr size_t WS_RMS = 66 * MiB;
constexpr size_t WS_H = 128 * MiB;
constexpr size_t WS_U = 256 * MiB;
constexpr size_t WS_END = 1024 * MiB;
constexpr int CW_BAR = 4096;

constexpr int RING_BYTES = 131072;
constexpr int LDSCTL_OFF = 156 * 1024, MISC_OFF = LDSCTL_OFF + 320;
constexpr int LDS_BYTES = 160 * 1024;
constexpr int NWAVES = 8;

__device__ __forceinline__ unsigned pk2(float lo, float hi) { f32x2 v = {lo, hi}; bf16x2_t b = __builtin_convertvector(v, bf16x2_t); return __builtin_bit_cast(unsigned, b); }
__device__ __forceinline__ float bflo(unsigned w) { return __uint_as_float(w << 16); }
__device__ __forceinline__ float bfhi(unsigned w) { return __uint_as_float(w & 0xffff0000u); }
__device__ __forceinline__ float wave_sum(float v) {
#pragma unroll
    for (int o = 1; o < 64; o <<= 1) v += __shfl_xor(v, o);
    return v;
}
__device__ __forceinline__ float sigmoidf_fast(float x) { return __builtin_amdgcn_rcpf(1.0f + __builtin_amdgcn_exp2f(-LOG2E * x)); }
__device__ __forceinline__ s16x4 ds_tr(const LAS unsigned char* p) { return __builtin_bit_cast(s16x4, __builtin_amdgcn_ds_read_tr16_b64_v4i16((LAS s16x4*)p)); }
__device__ __forceinline__ bf16x8 cat8(s16x4 lo, s16x4 hi) { return (bf16x8){lo[0], lo[1], lo[2], lo[3], hi[0], hi[1], hi[2], hi[3]}; }

namespace pg8 {
constexpr int BM = 256, BK = 64, HALF = 128, HTB = HALF * BK * 2, STAGE_BYTES = 8 * HTB, NXCD = 8, WGM = 8;
__host__ __device__ __forceinline__ int lds_byte(int r, int c) { const int st = (r >> 4) * 2 + (c >> 5), rr = r & 15, cc = c & 31, ob = rr * 64 + cc * 2; return st * 1024 + (ob ^ (((ob >> 9) & 1) << 5)); }
__host__ __device__ __forceinline__ void stage_rc(int b, int& R, int& C) { const int st = b / 1024, sb = b % 1024, swz = sb ^ (((sb >> 9) & 1) << 5); R = (st >> 1) * 16 + swz / 64; C = (st & 1) * 32 + (swz % 64) / 2; }
__host__ __device__ __forceinline__ int perm32(int rho) { const int n = rho >> 4, i = rho & 15; return 8 * (i >> 2) + 4 * n + (i & 3); }

struct Unit { int pm, pn; };
struct Gemm { const bf16* A; const bf16* Bt; int M, N, K, lda; };

struct StaticOrder {
    int nM, nN, nwg, G, c;
    __host__ __device__ void init(int M_, int N_, int G_, int c_) { nM = M_ / BM; nN = N_ / BM; nwg = nM * nN; G = G_; c = c_; }
    __host__ __device__ bool next(int i, Unit& u) const {
        const long L = (long)i * G + c; if (L >= nwg) return false;
        int wgid = (int)L; { const int q = nwg / NXCD, r = nwg % NXCD, xcd = wgid % NXCD, off = wgid / NXCD; wgid = (xcd < r ? xcd * (q + 1) : r * (q + 1) + (xcd - r) * q) + off; }
        const int nig = WGM * nN, gid = wgid / nig, fm = gid * WGM, gsz = (nM - fm) < WGM ? (nM - fm) : WGM;
        u.pm = fm + ((wgid % nig) % gsz); u.pn = (wgid % nig) / gsz; return true;
    }
    __device__ __forceinline__ void a_ready(const Unit&) const {}
    __device__ __forceinline__ void done(const Unit&) const {}
};

struct EpiPlain {
    static constexpr bool PERM = true, AFTER_DRAIN = false;
    bf16* O; int ldc;
    __device__ __forceinline__ void operator()(const f32x4 (&acc)[2][2][4][2], const Unit& u, int wr, int wc, int fr, int fq) const {
        const int row0 = u.pm * BM + wr * 64 + fr, col0 = u.pn * BM + wc * 32 + 8 * fq;
#pragma unroll
        for (int ai = 0; ai < 2; ++ai)
#pragma unroll
            for (int m = 0; m < 4; ++m) { bf16* rowp = O + (size_t)(row0 + ai * HALF + m * 16) * ldc + col0;
#pragma unroll
                for (int bj = 0; bj < 2; ++bj) { const f32x4 v0 = acc[ai][bj][m][0], v1 = acc[ai][bj][m][1];
                    u32x4 w; w.x = pk2(v0[0], v0[1]); w.y = pk2(v0[2], v0[3]); w.z = pk2(v1[0], v1[1]); w.w = pk2(v1[2], v1[3]);
                    *(u32x4*)(rowp + bj * HALF) = w; } }
    }
};
struct EpiNull {
    static constexpr bool PERM = true, AFTER_DRAIN = false;
    __device__ __forceinline__ void operator()(const f32x4 (&acc)[2][2][4][2], const Unit&, int, int, int, int) const {
#pragma unroll
        for (int ai = 0; ai < 2; ++ai)
#pragma unroll
            for (int bj = 0; bj < 2; ++bj)
#pragma unroll
                for (int m = 0; m < 4; ++m) asm volatile("" :: "v"(acc[ai][bj][m][0]), "v"(acc[ai][bj][m][1]));
    }
};
struct EpiRet {
    static constexpr bool PERM = true, AFTER_DRAIN = false;
    bf16* O; int ldc; const float* rcos; const float* rsin;
    __device__ __forceinline__ void operator()(const f32x4 (&acc)[2][2][4][2], const Unit& u, int wr, int wc, int fr, int fq) const {
        const int row0 = u.pm * BM + wr * 64 + fr, col0 = u.pn * BM + wc * 32 + 8 * fq;
        if (u.pn < 8) {
            const int h = u.pn & 3; const bool isk = u.pn >= 4;
            const float lg = log2f(1.0f - exp2f(-5.0f - (float)h));
            const float sgn = isk ? -lg : lg, mul = isk ? 0.0625f : 1.0f;
            const int d0 = wc * 32 + 8 * fq;
#pragma unroll
            for (int ai = 0; ai < 2; ++ai)
#pragma unroll
                for (int m = 0; m < 4; ++m) { const int row = row0 + ai * HALF + m * 16, t = row & (SEQ - 1), p = t & 63;
                    const float sc = mul * __builtin_amdgcn_exp2f((float)(p - 63) * sgn);
                    const float* cp = rcos + (size_t)t * 128 + d0; const float* sp = rsin + (size_t)t * 128 + d0;
                    u32x4 wx, wy;
                    { const f32x4 c0 = *(const f32x4*)cp, s0 = *(const f32x4*)sp; const f32x4 a0 = acc[ai][0][m][0], b0 = acc[ai][1][m][0];
                      const f32x4 x0 = (a0 * c0 - b0 * s0) * sc, y0 = (b0 * c0 + a0 * s0) * sc;
                      wx.x = pk2(x0[0], x0[1]); wx.y = pk2(x0[2], x0[3]); wy.x = pk2(y0[0], y0[1]); wy.y = pk2(y0[2], y0[3]); }
                    { const f32x4 c1 = *(const f32x4*)(cp + 4), s1 = *(const f32x4*)(sp + 4); const f32x4 a1 = acc[ai][0][m][1], b1 = acc[ai][1][m][1];
                      const f32x4 x1 = (a1 * c1 - b1 * s1) * sc, y1 = (b1 * c1 + a1 * s1) * sc;
                      wx.z = pk2(x1[0], x1[1]); wx.w = pk2(x1[2], x1[3]); wy.z = pk2(y1[0], y1[1]); wy.w = pk2(y1[2], y1[3]); }
                    bf16* rowp = O + (size_t)row * ldc + col0;
                    *(u32x4*)(rowp) = wx; *(u32x4*)(rowp + HALF) = wy;
                    asm volatile("" ::: "memory"); }
        } else {
#pragma unroll
            for (int ai = 0; ai < 2; ++ai)
#pragma unroll
                for (int m = 0; m < 4; ++m) { bf16* rowp = O + (size_t)(row0 + ai * HALF + m * 16) * ldc + col0;
#pragma unroll
                    for (int bj = 0; bj < 2; ++bj) { const f32x4 v0 = acc[ai][bj][m][0], v1 = acc[ai][bj][m][1];
                        u32x4 w; w.x = pk2(v0[0], v0[1]); w.y = pk2(v0[2], v0[3]); w.z = pk2(v1[0], v1[1]); w.w = pk2(v1[2], v1[3]);
                        *(u32x4*)(rowp + bj * HALF) = w; } }
        }
    }
};

template <class Epi, class Sched, bool ALIGN_EPI = false, bool SP2 = false>
__device__ __forceinline__ void gemm_phase(LAS unsigned char* lds, const Gemm g, const Sched& S, const Epi& E, const int tid) {
    const int wid = __builtin_amdgcn_readfirstlane(tid >> 6), lane = tid & 63, wr = wid >> 2, wc = wid & 3, fr = lane & 15, fq = lane >> 4;
    const int K = g.K, nt = K / BK, lda = g.lda;
    unsigned voffA[2], voffB[2];
#pragma unroll
    for (int i = 0; i < 2; ++i) { int R, C; stage_rc(tid * 16 + i * 8192, R, C); const int Rb = Epi::PERM ? ((R & ~31) + perm32(R & 31)) : R;
        voffA[i] = (unsigned)(R * lda + C) * 2u; voffB[i] = (unsigned)(Rb * K + C) * 2u; }
    const size_t kstep = (size_t)(BK * 2);
    const size_t hstepA = (size_t)HALF * lda * 2, hstepB = (size_t)HALF * K * 2;
    const size_t tstepA = 2 * hstepA, tstepB = 2 * hstepB;
    const unsigned ldsw = (unsigned)wid * 1024u;
    const int aoff = lds_byte(wr * 64 + fr, fq * 8), boff = lds_byte(wc * 32 + fr, fq * 8);
#define PG8_SA(b, h) (((b) * 2 + (h)) * HTB)
#define PG8_SB(b, h) ((4 + (b) * 2 + (h)) * HTB)
#define PG8_STAGE(bufoff, gbase, voff) do { _Pragma("unroll") for (int _i = 0; _i < 2; ++_i) \
        __builtin_amdgcn_global_load_lds((const unsigned*)((const char*)(gbase) + (voff)[_i]), (LAS unsigned*)(lds + (bufoff) + ldsw + _i * 8192), 16, 0, 0); } while (0)
#define PG8_LDA(dst, b, h) do { _Pragma("unroll") for (int m = 0; m < 4; ++m) _Pragma("unroll") for (int k = 0; k < 2; ++k) dst[m][k] = *(const LAS bf16x8*)(lds + PG8_SA(b, h) + aoff + m * 2048 + k * 1024); } while (0)
#define PG8_LDB(dst, b, h) do { _Pragma("unroll") for (int n = 0; n < 2; ++n) _Pragma("unroll") for (int k = 0; k < 2; ++k) dst[n][k] = *(const LAS bf16x8*)(lds + PG8_SB(b, h) + boff + n * 2048 + k * 1024); } while (0)
#define PG8_MMA(ai, bj, At, Bt) do { __builtin_amdgcn_s_setprio(1); _Pragma("unroll") for (int m = 0; m < 4; ++m) _Pragma("unroll") for (int n = 0; n < 2; ++n) _Pragma("unroll") for (int k = 0; k < 2; ++k) \
        acc[ai][bj][m][n] = __builtin_amdgcn_mfma_f32_16x16x32_bf16(Bt[n][k], At[m][k], acc[ai][bj][m][n], 0, 0, 0); __builtin_amdgcn_s_setprio(0); } while (0)
#define PG8_WAIT_V(n) asm volatile("s_waitcnt vmcnt(" #n ")" ::: "memory")
#define PG8_WAIT_L(n) asm volatile("s_waitcnt lgkmcnt(" #n ")" ::: "memory")
#define PG8_BAR __builtin_amdgcn_s_barrier()
#define PG8_SCHED __builtin_amdgcn_sched_barrier(0)
    Unit cur, nxt; int ui = 0;
    if (!S.next(0, cur)) return;
    f32x4 acc[2][2][4][2];
#pragma unroll
    for (int a = 0; a < 2; ++a)
#pragma unroll
        for (int b = 0; b < 2; ++b)
#pragma unroll
            for (int m = 0; m < 4; ++m)
#pragma unroll
                for (int n = 0; n < 2; ++n) acc[a][b][m][n] = (f32x4){0.f, 0.f, 0.f, 0.f};
    bf16x8 At[4][2], B0[2][2], B1[2][2];
    const char* cA = (const char*)g.A + (size_t)cur.pm * tstepA; const char* cB = (const char*)g.Bt + (size_t)cur.pn * tstepB;
    S.a_ready(cur);
    if constexpr (SP2) {
        PG8_STAGE(PG8_SB(0, 0), cB, voffB); PG8_STAGE(PG8_SB(0, 1), cB + hstepB, voffB); PG8_STAGE(PG8_SA(0, 0), cA, voffA); PG8_STAGE(PG8_SA(0, 1), cA + hstepA, voffA);
        if (wr == 1) PG8_BAR;
        PG8_WAIT_V(2); PG8_BAR;
        PG8_STAGE(PG8_SB(1, 0), cB + kstep, voffB); PG8_STAGE(PG8_SA(1, 0), cA + kstep, voffA); PG8_STAGE(PG8_SB(1, 1), cB + hstepB + kstep, voffB);
        PG8_WAIT_V(6); PG8_BAR;
    } else {
        PG8_STAGE(PG8_SB(0, 0), cB, voffB); PG8_STAGE(PG8_SA(0, 0), cA, voffA); PG8_STAGE(PG8_SB(0, 1), cB + hstepB, voffB); PG8_STAGE(PG8_SA(0, 1), cA + hstepA, voffA);
        if (wr == 1) PG8_BAR;
        PG8_WAIT_V(4); PG8_BAR;
        PG8_STAGE(PG8_SB(1, 0), cB + kstep, voffB); PG8_STAGE(PG8_SA(1, 0), cA + kstep, voffA); PG8_STAGE(PG8_SB(1, 1), cB + hstepB + kstep, voffB);
        PG8_WAIT_V(6); PG8_BAR;
    }
    for (;;) {
        const bool has_next = S.next(ui + 1, nxt);
        const char* nA = has_next ? (const char*)g.A + (size_t)nxt.pm * tstepA : cA; const char* nB = has_next ? (const char*)g.Bt + (size_t)nxt.pn * tstepB : cB;
        for (int t = 0; t < nt; t += 2) {
            const bool last = (t == nt - 2);
            const char* a1 = cA + (size_t)(t + 1) * kstep;
            const char* a2 = last ? nA : cA + (size_t)(t + 2) * kstep; const char* b2 = last ? nB : cB + (size_t)(t + 2) * kstep;
            const char* a3 = a2 + kstep; const char* b3 = b2 + kstep;
            if (last && has_next) S.a_ready(nxt);
            if constexpr (SP2) {
            PG8_LDB(B0, 0, 0); PG8_LDB(B1, 0, 1); PG8_SCHED; PG8_LDA(At, 0, 0); PG8_STAGE(PG8_SA(1, 1), a1 + hstepA, voffA);
            PG8_WAIT_V(8); PG8_WAIT_L(0); PG8_BAR; PG8_MMA(0, 0, At, B0); PG8_MMA(0, 1, At, B1); PG8_BAR; PG8_SCHED;
            PG8_LDA(At, 0, 1); PG8_STAGE(PG8_SB(0, 0), b2, voffB); PG8_STAGE(PG8_SB(0, 1), b2 + hstepB, voffB); PG8_STAGE(PG8_SA(0, 0), a2, voffA);
            PG8_WAIT_V(8); PG8_WAIT_L(0); PG8_BAR; PG8_MMA(1, 0, At, B0); PG8_MMA(1, 1, At, B1); PG8_BAR; PG8_SCHED;
            PG8_LDB(B0, 1, 0); PG8_LDB(B1, 1, 1); PG8_SCHED; PG8_LDA(At, 1, 0); PG8_STAGE(PG8_SA(0, 1), a2 + hstepA, voffA);
            PG8_WAIT_V(8); PG8_WAIT_L(0); PG8_BAR; PG8_MMA(0, 0, At, B0); PG8_MMA(0, 1, At, B1); PG8_BAR; PG8_SCHED;
            PG8_LDA(At, 1, 1); PG8_STAGE(PG8_SB(1, 0), b3, voffB); PG8_STAGE(PG8_SB(1, 1), b3 + hstepB, voffB); PG8_STAGE(PG8_SA(1, 0), a3, voffA);
            PG8_WAIT_V(8); PG8_WAIT_L(0); PG8_BAR; PG8_MMA(1, 0, At, B0); PG8_MMA(1, 1, At, B1); PG8_BAR; PG8_SCHED;
            } else {
            PG8_LDB(B0, 0, 0); PG8_SCHED; PG8_LDA(At, 0, 0); PG8_STAGE(PG8_SA(1, 1), a1 + hstepA, voffA);
            PG8_WAIT_L(8); PG8_BAR; PG8_WAIT_L(0); PG8_MMA(0, 0, At, B0); PG8_BAR; PG8_SCHED;
            PG8_LDB(B1, 0, 1); PG8_STAGE(PG8_SB(0, 0), b2, voffB);
            PG8_BAR; PG8_WAIT_L(0); PG8_MMA(0, 1, At, B1); PG8_BAR;
            PG8_LDA(At, 0, 1); PG8_STAGE(PG8_SA(0, 0), a2, voffA);
            PG8_BAR; PG8_WAIT_L(0); PG8_MMA(1, 0, At, B0); PG8_BAR; PG8_SCHED;
            PG8_STAGE(PG8_SB(0, 1), b2 + hstepB, voffB);
            PG8_WAIT_V(6); PG8_BAR; PG8_MMA(1, 1, At, B1); PG8_BAR;
            PG8_LDB(B0, 1, 0); PG8_SCHED; PG8_LDA(At, 1, 0); PG8_STAGE(PG8_SA(0, 1), a2 + hstepA, voffA);
            PG8_WAIT_L(8); PG8_BAR; PG8_WAIT_L(0); PG8_MMA(0, 0, At, B0); PG8_BAR; PG8_SCHED;
            PG8_LDB(B1, 1, 1); PG8_STAGE(PG8_SB(1, 0), b3, voffB);
            PG8_BAR; PG8_WAIT_L(0); PG8_MMA(0, 1, At, B1); PG8_BAR;
            PG8_LDA(At, 1, 1); PG8_STAGE(PG8_SA(1, 0), a3, voffA);
            PG8_BAR; PG8_WAIT_L(0); PG8_MMA(1, 0, At, B0); PG8_BAR; PG8_SCHED;
            PG8_STAGE(PG8_SB(1, 1), b3 + hstepB, voffB);
            PG8_WAIT_V(6); PG8_BAR; PG8_MMA(1, 1, At, B1); PG8_BAR;
            }
        }
        if constexpr (ALIGN_EPI) { if (wr == 0) PG8_BAR; }
        if constexpr (!Epi::AFTER_DRAIN) { E(acc, cur, wr, wc, fr, fq); S.done(cur); }
        if (!has_next) break;
#pragma unroll
        for (int a = 0; a < 2; ++a)
#pragma unroll
            for (int b = 0; b < 2; ++b)
#pragma unroll
                for (int m = 0; m < 4; ++m)
#pragma unroll
                    for (int n = 0; n < 2; ++n) acc[a][b][m][n] = (f32x4){0.f, 0.f, 0.f, 0.f};
        cur = nxt; cA = nA; cB = nB; ++ui;
        if constexpr (ALIGN_EPI) { if (wr == 1) PG8_BAR; }
    }
    PG8_WAIT_V(0);
    if constexpr (!ALIGN_EPI) { if (wr == 0) PG8_BAR; }
    PG8_BAR;
#undef PG8_SA
#undef PG8_SB
#undef PG8_STAGE
#undef PG8_LDA
#undef PG8_LDB
#undef PG8_MMA
#undef PG8_WAIT_V
#undef PG8_WAIT_L
#undef PG8_BAR
#undef PG8_SCHED
}
}

#define XB_TMO      128
#define XB_XCNT(j)  (256  + 64 * (j))
#define XB_XSUB(j)  (1280 + 64 * (j))
#define XB_XGEN(j)  (2304 + 64 * (j))
#define XB_TOP      3328
#define XB_TOPGEN   3392
#define XCD_BAR_WORDS 3456
#define XB_SPIN_CAP (1u << 18)

__device__ __forceinline__ unsigned xb_ld(unsigned* p)              { return __hip_atomic_load(p, __ATOMIC_RELAXED, __HIP_MEMORY_SCOPE_AGENT); }
__device__ __forceinline__ unsigned xb_add(unsigned* p, unsigned v) { return __hip_atomic_fetch_add(p, v, __ATOMIC_RELAXED, __HIP_MEMORY_SCOPE_AGENT); }
__device__ __forceinline__ unsigned xb_xcc_id() { return (unsigned)__builtin_amdgcn_s_getreg((3 << 11) | 20) & 0xFu; }
#define XB_SPIN(cond, bar) do { unsigned _sp = 0; while (cond) { __builtin_amdgcn_s_sleep(1); \
    if ((++_sp & 255u) == 0u) { if (xb_ld(&(bar)[XB_TMO])) break; if (_sp > XB_SPIN_CAP) { atomicAdd(&(bar)[XB_TMO], 1u); break; } } } } while (0)

struct XcdBarrier {
    unsigned* bar; unsigned x;
    volatile LAS unsigned* st;
};
__device__ __forceinline__ XcdBarrier xcd_barrier_post(unsigned* bar, volatile LAS unsigned* st) {
    XcdBarrier b; b.bar = bar; b.x = xb_xcc_id(); b.st = st;
    if (threadIdx.x == 0) (void)xb_add(&bar[XB_XCNT(b.x)], 1u);
    return b;
}
__device__ __forceinline__ void xcd_barrier_complete(unsigned* bar, unsigned x, unsigned& nloc, unsigned& nx) {
    const unsigned G = gridDim.x * gridDim.y * gridDim.z;
    unsigned sum, cnt, mine, sp = 0u;
    for (;;) {
        sum = 0u; cnt = 0u; mine = 0u;
#pragma unroll
        for (unsigned j = 0; j < 16; ++j) { const unsigned c = xb_ld(&bar[XB_XCNT(j)]); sum += c; cnt += (c > 0u) ? 1u : 0u; mine = (j == x) ? c : mine; }
        if (sum == G) break;
        __builtin_amdgcn_s_sleep(1);
        if ((++sp & 255u) == 0u) { if (xb_ld(&bar[XB_TMO])) break; if (sp > XB_SPIN_CAP) { atomicAdd(&bar[XB_TMO], 1u); break; } }
    }
    nloc = mine > 0u ? mine : 1u; nx = cnt > 0u ? cnt : 1u;
}
__device__ __forceinline__ void xcd_barrier(const XcdBarrier& b) {
    asm volatile("s_waitcnt vmcnt(0)" ::: "memory");
    __syncthreads();
    if (threadIdx.x == 0) {
        unsigned* bar = b.bar;
        __builtin_amdgcn_s_waitcnt(0);
        unsigned nloc = b.st[0], nx = b.st[1];
        if (nloc == 0u) { xcd_barrier_complete(bar, b.x, nloc, nx); b.st[0] = nloc; b.st[1] = nx; }
        const unsigned old = xb_add(&bar[XB_XSUB(b.x)], 1u);
        const unsigned gen = old / nloc;
        if (old + 1u == (gen + 1u) * nloc) {
            __builtin_amdgcn_fence(__ATOMIC_RELEASE, "agent");
            asm volatile("s_waitcnt vmcnt(0)" ::: "memory");
            const unsigned og = xb_add(&bar[XB_TOP], 1u);
            const unsigned tg = og / nx;
            if (og + 1u == (tg + 1u) * nx) xb_add(&bar[XB_TOPGEN], 1u);
            else XB_SPIN(xb_ld(&bar[XB_TOPGEN]) == tg, bar);
            __builtin_amdgcn_fence(__ATOMIC_ACQUIRE, "agent");
            xb_add(&bar[XB_XGEN(b.x)], 1u);
            asm volatile("s_waitcnt vmcnt(0)" ::: "memory");
        } else {
            XB_SPIN(xb_ld(&bar[XB_XGEN(b.x)]) == gen, bar);
            __builtin_amdgcn_fence(__ATOMIC_ACQUIRE, "agent");
            asm volatile("s_waitcnt vmcnt(0)" ::: "memory");
        }
    }
    __syncthreads();
}

__device__ __forceinline__ void p0_transpose_item(const float* W, int K, int N, bf16* WT, LAS float* scr, int item, int lane, const float* gain) {
    const int nblk = N / 32, kb = item / nblk, nb = item % nblk, k0 = 64 * kb, n0 = 32 * nb;
#pragma unroll 8
    for (int i = 0; i < 32; ++i) { const int kk = 2 * i + (lane >> 5); scr[kk * 33 + (lane & 31)] = W[(size_t)(k0 + kk) * N + n0 + (lane & 31)] * (gain ? gain[k0 + kk] : 1.0f); }
    asm volatile("s_waitcnt lgkmcnt(0)" ::: "memory");
    const int c = lane & 7;
#pragma unroll
    for (int j = 0; j < 4; ++j) { const int n = (lane >> 3) + 8 * j; const LAS float* s = scr + (8 * c) * 33 + n;
        u32x4 o; o.x = pk2(s[0 * 33], s[1 * 33]); o.y = pk2(s[2 * 33], s[3 * 33]); o.z = pk2(s[4 * 33], s[5 * 33]); o.w = pk2(s[6 * 33], s[7 * 33]);
        *(u32x4*)(WT + (size_t)(n0 + n) * K + k0 + 8 * c) = o; }
    asm volatile("s_waitcnt lgkmcnt(0)" ::: "memory");
}
__device__ __forceinline__ void sincos_d(double x, double& s, double& c) {
    const double TWO_OVER_PI = 0.63661977236758134308, PIO2_HI = 1.57079632679489655800, PIO2_LO = 6.12323399573676603587e-17;
    const double kq = __builtin_rint(x * TWO_OVER_PI); const int q = (int)kq;
    const double r = (x - kq * PIO2_HI) - kq * PIO2_LO, r2 = r * r;
    double sp = -1.0 / 1307674368000.0; sp = sp * r2 + 1.0 / 6227020800.0; sp = sp * r2 - 1.0 / 39916800.0; sp = sp * r2 + 1.0 / 362880.0; sp = sp * r2 - 1.0 / 5040.0; sp = sp * r2 + 1.0 / 120.0; sp = sp * r2 - 1.0 / 6.0;
    const double sr = r + r * r2 * sp;
    double cp = 1.0 / 20922789888000.0; cp = cp * r2 - 1.0 / 87178291200.0; cp = cp * r2 + 1.0 / 479001600.0; cp = cp * r2 - 1.0 / 3628800.0; cp = cp * r2 + 1.0 / 40320.0; cp = cp * r2 - 1.0 / 720.0; cp = cp * r2 + 1.0 / 24.0; cp = cp * r2 - 0.5;
    const double cr = 1.0 + r2 * cp;
    const bool swp = (q & 1) != 0; const double s0 = swp ? cr : sr, c0 = swp ? sr : cr;
    s = (q & 2) ? -s0 : s0; c = ((q + 1) & 2) ? -c0 : c0;
}

struct Args { const float* in[14]; float* out; unsigned char* ws; int ph_lo, ph_hi; };
typedef const __attribute__((address_space(4))) Args* KArgs;

__device__ __forceinline__ void rms_row_to_bf16(const float* xrow, bf16* orow, float* rms, int lane) {
    const f32x4* xr = (const f32x4*)xrow + lane; f32x4 v[4]; float s = 0.f;
#pragma unroll
    for (int j = 0; j < 4; ++j) { v[j] = xr[64 * j]; s += (v[j].x * v[j].x + v[j].y * v[j].y) + (v[j].z * v[j].z + v[j].w * v[j].w); }
    const float ms = wave_sum(s) * (1.0f / DM) + RMS_EPS, rinv = 1.0f / sqrtf(ms);
    if (lane == 0) *rms = sqrtf(ms);
    u32x2* o8 = (u32x2*)orow + lane;
#pragma unroll
    for (int j = 0; j < 4; ++j) { u32x2 w; w.x = pk2(v[j].x * rinv, v[j].y * rinv); w.y = pk2(v[j].z * rinv, v[j].w * rinv); o8[64 * j] = w; }
}

__device__ __forceinline__ void p0_prologue(LAS unsigned char* lds, KArgs ap, int G, int vcu, int tid) {
    const int lane = tid & 63, wave = __builtin_amdgcn_readfirstlane(tid >> 6);
    unsigned char* ws = ap->ws;
    LAS float* scr = (LAS float*)(lds + wave * 16384);
    const int gw = vcu * NWAVES + wave, NGW = G * NWAVES;
    constexpr int I_LIN = (DM / 64) * (NLRU / 32), I_LOUT = (DRNN / 64) * (DM / 32), I_RIN = (DM / 64) * (NRET / 32), I_ROUT = (VD / 64) * (DM / 32);
    constexpr int I_PER = I_LIN + I_LOUT + I_RIN + I_ROUT, NITEMS = 2 * I_PER;
    for (int it = gw; it < NITEMS; it += NGW) {
        const int j = it / I_PER; int r = it % I_PER;
        if (r < I_LIN) { p0_transpose_item(ap->in[3] + (size_t)j * DM * NLRU, DM, NLRU, (bf16*)(ws + WS_WLIN) + (size_t)j * NLRU * DM, scr, r, lane, ap->in[1] + (size_t)(2 * j) * DM); continue; } r -= I_LIN;
        if (r < I_LOUT) { p0_transpose_item(ap->in[11] + (size_t)j * DRNN * DM, DRNN, DM, (bf16*)(ws + WS_WLOUT) + (size_t)j * DM * DRNN, scr, r, lane, nullptr); continue; } r -= I_LOUT;
        if (r < I_RIN) { p0_transpose_item(ap->in[12] + (size_t)j * DM * NRET, DM, NRET, (bf16*)(ws + WS_WRIN) + (size_t)j * NRET * DM, scr, r, lane, ap->in[1] + (size_t)(2 * j + 1) * DM); continue; } r -= I_RIN;
        p0_transpose_item(ap->in[13] + (size_t)j * VD * DM, VD, DM, (bf16*)(ws + WS_WROUT) + (size_t)j * DM * VD, scr, r, lane, nullptr);
    }
    const int gt = vcu * (NWAVES * 64) + tid, NGT = G * NWAVES * 64;
    { bf16* gw_t = (bf16*)(ws + WS_GATEW);
      for (int o = gt; o < 2 * 2 * NGB * BW * BW; o += NGT) {
          const int cin = o % BW, cout = (o / BW) % BW, n = (o / (BW * BW)) % NGB, mat = (o / (NGB * BW * BW)) % 2, j = o / (2 * NGB * BW * BW);
          const float* src = (mat ? ap->in[8] : ap->in[6]) + (size_t)j * NGB * BW * BW + (size_t)n * BW * BW + cin * BW + cout;
          gw_t[o] = (bf16)(pk2(*src * (-LOG2E), 0.f) & 0xffffu); } }
    { float* rc = (float*)(ws + WS_ROPE); float* rs = rc + SEQ * 128;
      for (int o = gt; o < SEQ * 128; o += NGT) {
          const int i = o & 127, t = o >> 7;
          double f = 1.0, bpow = 0.93057204092969897;
          int e = i; while (e) { if (e & 1) f *= bpow; bpow *= bpow; e >>= 1; }
          const double ang = (double)t * f;
          const double TWO_PI_HI = 6.28318530717958623200, TWO_PI_LO = 2.44929359829470641435e-16;
          const double k = __builtin_rint(ang * 0.15915494309189533577);
          const double x = (ang - k * TWO_PI_HI) - k * TWO_PI_LO;
          double s, c; sincos_d(x, s, c);
          rc[o] = (float)c; rs[o] = (float)s; } }
    for (int m = gw; m < M; m += NGW) rms_row_to_bf16(ap->in[0] + (size_t)m * DM, (bf16*)(ws + WS_H) + (size_t)m * DM, (float*)(ws + WS_RMS) + m, lane);
}

__device__ __forceinline__ void norm_phase(bf16* XN, float* RMS, const bf16* O, int ldo, const float* gpost, float* out, bool last, int G, int vcu, int tid) {
    const int lane = tid & 63, wave = __builtin_amdgcn_readfirstlane(tid >> 6);
    const int gw = vcu * NWAVES + wave, NGW = G * NWAVES;
    f32x4 gp[4];
#pragma unroll
    for (int j = 0; j < 4; ++j) gp[j] = ((const f32x4*)gpost)[lane + 64 * j];
    for (int m = gw; m < M; m += NGW) {
        const u32x2* orow = (const u32x2*)(O + (size_t)m * ldo) + lane; u32x2* xrow = (u32x2*)(XN + (size_t)m * DM) + lane;
        const float rms = RMS[m];
        f32x4 o[4], x[4]; float s = 0.f;
#pragma unroll
        for (int j = 0; j < 4; ++j) { const u32x2 w = orow[64 * j], xw = xrow[64 * j]; o[j] = (f32x4){bflo(w.x), bfhi(w.x), bflo(w.y), bfhi(w.y)}; x[j] = (f32x4){bflo(xw.x), bfhi(xw.x), bflo(xw.y), bfhi(xw.y)};
            s += (o[j].x * o[j].x + o[j].y * o[j].y) + (o[j].z * o[j].z + o[j].w * o[j].w); }
        const float rinv = 1.0f / sqrtf(wave_sum(s) * (1.0f / DM) + RMS_EPS);
        float s2 = 0.f;
#pragma unroll
        for (int j = 0; j < 4; ++j) { x[j] = x[j] * rms + o[j] * rinv * gp[j]; s2 += (x[j].x * x[j].x + x[j].y * x[j].y) + (x[j].z * x[j].z + x[j].w * x[j].w); }
        if (last) { f32x4* outr = (f32x4*)(out + (size_t)m * DM) + lane;
#pragma unroll
            for (int j = 0; j < 4; ++j) outr[64 * j] = x[j];
        } else {
            const float ms = wave_sum(s2) * (1.0f / DM) + RMS_EPS, rinv2 = 1.0f / sqrtf(ms);
            if (lane == 0) RMS[m] = sqrtf(ms);
#pragma unroll
            for (int j = 0; j < 4; ++j) { const f32x4 hv = x[j] * rinv2; u32x2 w; w.x = pk2(hv.x, hv.y); w.y = pk2(hv.z, hv.w); xrow[64 * j] = w; }
        }
    }
}

constexpr int LR_T = 128, LR_RAW = 0, LR_GATE = 25600, LR_XBC = 50176, LR_XBS = 208, LR_WT = 76800, LR_WTS = 208, LR_WTM = 96 * LR_WTS, LR_TOT = LR_WT + 2 * LR_WTM, LR_HP = LR_TOT + 8 * 96 * 8, LR_YT = LR_HP + 768, LR_CW = LR_YT + 128 * 192;
static_assert(LR_CW + 12 * 160 <= LDSCTL_OFF, "LRU LDS map");
template <bool DRY> __device__ __forceinline__ void lru_phase(LAS unsigned char* lds, bf16* U, bf16* dry, const bf16* gatew  , const float* conv_w, const float* conv_b,
                                          const float* b_a, const float* b_x, const float* lam, int G, int bid, int tid) {
    constexpr int ABL = DRY ? LRU_ABL : 0;
    const int lane = tid & 63, w = __builtin_amdgcn_readfirstlane(tid >> 6), i16 = lane & 15, kg = lane >> 4;
    const int cch = tid % 12, ctr = tid / 12; const bool stg = tid < 504;
    unsigned goff[3]; LAS unsigned char* rawp[3]; LAS unsigned char* gatp[3];
#pragma unroll
    for (int k = 0; k < 3; ++k) { const int q = tid + 512 * k, rr = q / 12, ch = q % 12; goff[k] = (unsigned)((rr * NLRU + ch * 8) * 2);
        rawp[k] = lds + LR_RAW + (rr + 3) * 192 + ch * 16; gatp[k] = lds + LR_GATE + rr * 192 + ch * 16; }
    asm volatile("" : "+v"(goff[0]), "+v"(goff[1]), "+v"(goff[2]), "+v"(rawp[0]), "+v"(rawp[1]), "+v"(rawp[2]), "+v"(gatp[0]), "+v"(gatp[1]), "+v"(gatp[2]));
    LAS unsigned char* halo = lds + LR_RAW + (tid / 12) * 192 + (tid % 12) * 16;
    LAS unsigned char* rawc = lds + LR_RAW + ctr * 192 + cch * 16;
    LAS unsigned char* xbwp = lds + LR_XBC + ctr * LR_XBS + cch * 16;
    LAS unsigned char* xard = lds + LR_XBC + (16 * w + i16) * LR_XBS + 16 * kg;
    LAS unsigned char* wtrd = lds + LR_WT + i16 * LR_WTS + 16 * kg;
    LAS unsigned char* xbel = lds + LR_XBC + (16 * w + 4 * kg) * LR_XBS + i16 * 2;
    LAS unsigned char* gtel = lds + LR_GATE + (16 * w + 4 * kg) * 192 + i16 * 2;
    LAS unsigned char* totw = lds + LR_TOT + (w * 96 + i16) * 8;
    LAS unsigned char* totr = lds + LR_TOT + i16 * 8;
    asm volatile("" : "+v"(halo), "+v"(rawc), "+v"(xbwp), "+v"(xard), "+v"(wtrd));
    asm volatile("" : "+v"(xbel), "+v"(gtel), "+v"(totw), "+v"(totr));
    for (int unit = bid; unit < BATCH * NGB; unit += G) {
        const int b = unit >> 4, n = unit & 15;
        bf16* ub = U + (size_t)b * SEQ * NLRU + n * BW;
        if (tid < 480) { const int c12 = tid / 40, j = tid % 40, k = j >> 3, e = j & 7;
            *(LAS float*)(lds + LR_CW + tid * 4) = (k < 4) ? conv_w[k * DRNN + n * BW + c12 * 8 + e] : conv_b[n * BW + c12 * 8 + e]; }
        float ba6[6], bx6[6], cc6[6];
#pragma unroll
        for (int c6 = 0; c6 < 6; ++c6) { const int c = n * BW + 16 * c6 + i16; ba6[c6] = -LOG2E * b_a[c]; bx6[c6] = -LOG2E * b_x[c]; cc6[c6] = -8.0f * log1pf(expf(-lam[c])) * LOG2E; }
        for (int q = tid; q < 2 * 96 * 12; q += 512) { const int mat = q / 1152, rr = (q % 1152) / 12, ch = q % 12;
            *(LAS u32x4*)(lds + LR_WT + mat * LR_WTM + rr * LR_WTS + ch * 16) = *(const u32x4*)(gatew + (size_t)mat * NGB * BW * BW + ((size_t)n * BW + rr) * BW + ch * 8); }
        if (tid < 192) *(LAS float*)(lds + LR_HP + tid * 4) = 0.f;
        u32x4 pfr[3], pfg[3], hreg = (u32x4){0u, 0u, 0u, 0u};
#pragma unroll
        for (int k = 0; k < 3; ++k) { pfr[k] = *(const u32x4*)((const char*)ub + goff[k]); pfg[k] = *(const u32x4*)((const char*)(ub + DRNN) + goff[k]); }
#pragma unroll 1
        for (int ti = 0; ti < SEQ / LR_T; ++ti) {
            const int t0 = ti * LR_T;
#pragma unroll
            for (int k = 0; k < 3; ++k) { *(LAS u32x4*)rawp[k] = pfr[k]; *(LAS u32x4*)gatp[k] = pfg[k]; }
            if (tid < 36) *(LAS u32x4*)halo = hreg;
            __syncthreads();
            if (ti > 0 && !(ABL & 8)) {
#pragma unroll
                for (int k = 0; k < 3; ++k) { const u32x4 yv = *(const LAS u32x4*)(gatp[k] + (LR_YT - LR_GATE));
                    if (DRY) *(u32x4*)(dry + ((size_t)b * SEQ + t0 - LR_T + (tid + 512 * k) / 12) * DM + n * 64 + (cch & 7) * 8) = yv;
                    else *(u32x4*)((char*)(ub + (size_t)(t0 - LR_T) * NLRU + DRNN) + goff[k]) = yv; } }
            if constexpr (!(ABL & 4)) { const int t1 = (ti + 1 < SEQ / LR_T) ? t0 + LR_T : t0;
#pragma unroll
              for (int k = 0; k < 3; ++k) { pfr[k] = *(const u32x4*)((const char*)(ub + (size_t)t1 * NLRU) + goff[k]); pfg[k] = *(const u32x4*)((const char*)(ub + (size_t)t1 * NLRU + DRNN) + goff[k]); } }
            if (stg && !(ABL & 2)) {
#pragma unroll
                for (int k4 = 0; k4 < 4; ++k4) {
                    if (ctr + 42 * k4 < LR_T) {
                        const LAS f32x4* tp = (const LAS f32x4*)(lds + LR_CW + cch * 160);
                        f32x4 b0 = tp[8], b1 = tp[9];
                        f32x2 acc2[4] = {(f32x2){b0.x, b0.y}, (f32x2){b0.z, b0.w}, (f32x2){b1.x, b1.y}, (f32x2){b1.z, b1.w}};
#pragma unroll
                        for (int k = 0; k < 4; ++k) { const u32x4 rv = *(const LAS u32x4*)(rawc + k4 * 42 * 192 + k * 192); const f32x4 w0 = tp[2 * k], w1 = tp[2 * k + 1];
                            acc2[0] += (f32x2){w0.x, w0.y} * (f32x2){bflo(rv.x), bfhi(rv.x)}; acc2[1] += (f32x2){w0.z, w0.w} * (f32x2){bflo(rv.y), bfhi(rv.y)};
                            acc2[2] += (f32x2){w1.x, w1.y} * (f32x2){bflo(rv.z), bfhi(rv.z)}; acc2[3] += (f32x2){w1.z, w1.w} * (f32x2){bflo(rv.w), bfhi(rv.w)}; }
                        u32x4 o; o.x = pk2(acc2[0].x, acc2[0].y); o.y = pk2(acc2[1].x, acc2[1].y); o.z = pk2(acc2[2].x, acc2[2].y); o.w = pk2(acc2[3].x, acc2[3].y);
                        *(LAS u32x4*)(xbwp + k4 * 42 * LR_XBS) = o; } } }
            __syncthreads();
            if (tid < 36) hreg = *(const LAS u32x4*)(halo + 128 * 192);
            float hloc[6][4], acum[6][4];
            if constexpr (ABL & 1) {
#pragma unroll
                for (int c6 = 0; c6 < 6; ++c6)
#pragma unroll
                    for (int r = 0; r < 4; ++r) { hloc[c6][r] = 0.f; acum[c6][r] = 0.f; } }
            if constexpr (!(ABL & 1)) { bf16x8 xa[3];
#pragma unroll
              for (int s = 0; s < 3; ++s) xa[s] = *(const LAS bf16x8*)(xard + s * 64);
#pragma unroll
              for (int c6 = 0; c6 < 6; ++c6) {
                f32x4 ra = {ba6[c6], ba6[c6], ba6[c6], ba6[c6]}, ri = {bx6[c6], bx6[c6], bx6[c6], bx6[c6]};
#pragma unroll
                for (int s = 0; s < 3; ++s) { const bf16x8 wa = *(const LAS bf16x8*)(wtrd + c6 * 16 * LR_WTS + s * 64), wx = *(const LAS bf16x8*)(wtrd + LR_WTM + c6 * 16 * LR_WTS + s * 64);
                    ra = __builtin_amdgcn_mfma_f32_16x16x32_bf16(xa[s], wa, ra, 0, 0, 0); ri = __builtin_amdgcn_mfma_f32_16x16x32_bf16(xa[s], wx, ri, 0, 0, 0); }
                f32x2 xv[2], er[2], ei[2];
#pragma unroll
                for (int p = 0; p < 2; ++p) {
                    xv[p] = (f32x2){__uint_as_float((unsigned)(*(const LAS unsigned short*)(xbel + (2 * p) * LR_XBS + c6 * 32)) << 16), __uint_as_float((unsigned)(*(const LAS unsigned short*)(xbel + (2 * p + 1) * LR_XBS + c6 * 32)) << 16)};
                    er[p] = (f32x2){__builtin_amdgcn_exp2f(ra[2 * p]), __builtin_amdgcn_exp2f(ra[2 * p + 1])} + 1.0f;
                    ei[p] = (f32x2){__builtin_amdgcn_exp2f(ri[2 * p]), __builtin_amdgcn_exp2f(ri[2 * p + 1])} + 1.0f; }
                f32x2 av2[2], bv2[2];
#pragma unroll
                for (int p = 0; p < 2; ++p) {
                    const f32x2 rr = (f32x2){__builtin_amdgcn_rcpf(er[p].x), __builtin_amdgcn_rcpf(er[p].y)}, ii = (f32x2){__builtin_amdgcn_rcpf(ei[p].x), __builtin_amdgcn_rcpf(ei[p].y)};
                    const f32x2 tt = rr * cc6[c6];
                    av2[p] = (f32x2){__builtin_amdgcn_exp2f(tt.x), __builtin_amdgcn_exp2f(tt.y)};
                    const f32x2 om = 1.0f - av2[p] * av2[p];
                    bv2[p] = (f32x2){__builtin_amdgcn_sqrtf(om.x), __builtin_amdgcn_sqrtf(om.y)} * (ii * xv[p]); }
                float av[4], bv[4];
                { const f32x2 ae = (f32x2){av2[0].x, av2[1].x}, ao = (f32x2){av2[0].y, av2[1].y}, be = (f32x2){bv2[0].x, bv2[1].x}, bo = (f32x2){bv2[0].y, bv2[1].y};
                  const f32x2 b01 = ao * be + bo, a01 = ae * ao;
                  av[0] = ae.x; bv[0] = be.x; av[1] = a01.x; bv[1] = b01.x;
                  const f32x2 a2 = (f32x2){ae.y, a01.y}, b2 = (f32x2){be.y, b01.y};
                  const f32x2 bq = a2 * b01.x + b2, aq = a2 * a01.x;
                  av[2] = aq.x; bv[2] = bq.x; av[3] = aq.y; bv[3] = bq.y; }
                float At = av[3], Bt = bv[3];
                { const float Ap = __shfl_up(At, 16), Bp = __shfl_up(Bt, 16); if (kg >= 1) { Bt = fmaf(At, Bp, Bt); At *= Ap; } }
                { const float Ap = __shfl_up(At, 32), Bp = __shfl_up(Bt, 32); if (kg >= 2) { Bt = fmaf(At, Bp, Bt); At *= Ap; } }
                float Ae = __shfl_up(At, 16), Be = __shfl_up(Bt, 16); if (kg == 0) { Ae = 1.0f; Be = 0.f; }
                { const f32x2 h01 = (f32x2){av[0], av[1]} * Be + (f32x2){bv[0], bv[1]}, h23 = (f32x2){av[2], av[3]} * Be + (f32x2){bv[2], bv[3]};
                  const f32x2 c01 = (f32x2){av[0], av[1]} * Ae, c23 = (f32x2){av[2], av[3]} * Ae;
                  hloc[c6][0] = h01.x; hloc[c6][1] = h01.y; hloc[c6][2] = h23.x; hloc[c6][3] = h23.y; acum[c6][0] = c01.x; acum[c6][1] = c01.y; acum[c6][2] = c23.x; acum[c6][3] = c23.y; }
                if (kg == 3) *(LAS f32x2*)(totw + c6 * 128) = (f32x2){At, Bt};
                if (c6 == 2) __builtin_amdgcn_sched_barrier(0);
              } }
            __syncthreads();
            if constexpr (!(ABL & 1)) { const int hp = (ti & 1) * 384;
#pragma unroll
              for (int c6 = 0; c6 < 6; ++c6) {
                float carry = *(const LAS float*)(lds + LR_HP + hp + (16 * c6 + i16) * 4);
                for (int t = 0; t < w; ++t) { const f32x2 ab = *(const LAS f32x2*)(totr + t * 768 + c6 * 128); carry = fmaf(ab.x, carry, ab.y); }
                if (w == 7 && kg == 0) { const f32x2 ab = *(const LAS f32x2*)(totr + 7 * 768 + c6 * 128); *(LAS float*)(lds + LR_HP + (384 - hp) + (16 * c6 + i16) * 4) = fmaf(ab.x, carry, ab.y); }
#pragma unroll
                for (int p = 0; p < 2; ++p) {
                    LAS unsigned short* gp0 = (LAS unsigned short*)(gtel + (2 * p) * 192 + c6 * 32); LAS unsigned short* gp1 = (LAS unsigned short*)(gtel + (2 * p + 1) * 192 + c6 * 32);
                    const f32x2 gv = (f32x2){__uint_as_float((unsigned)(*gp0) << 16), __uint_as_float((unsigned)(*gp1) << 16)};
                    const f32x2 hv = (f32x2){acum[c6][2 * p], acum[c6][2 * p + 1]} * carry + (f32x2){hloc[c6][2 * p], hloc[c6][2 * p + 1]};
                    const f32x2 eg = gv * (-LOG2E); const f32x2 dg = (f32x2){__builtin_amdgcn_exp2f(eg.x), __builtin_amdgcn_exp2f(eg.y)} + 1.0f;
                    const f32x2 yv = hv * gv * (f32x2){__builtin_amdgcn_rcpf(dg.x), __builtin_amdgcn_rcpf(dg.y)};
                    const unsigned yw = pk2(yv.x, yv.y);
                    *(LAS unsigned short*)((LAS unsigned char*)gp0 + (LR_YT - LR_GATE)) = (unsigned short)(yw & 0xffffu); *(LAS unsigned short*)((LAS unsigned char*)gp1 + (LR_YT - LR_GATE)) = (unsigned short)(yw >> 16); }
              } }
            __syncthreads();
        }
#pragma unroll
        for (int k = 0; k < 3; ++k) { const u32x4 yv = *(const LAS u32x4*)(gatp[k] + (LR_YT - LR_GATE));
            if (DRY) *(u32x4*)(dry + ((size_t)b * SEQ + SEQ - LR_T + (tid + 512 * k) / 12) * DM + n * 64 + (cch & 7) * 8) = yv;
            else *(u32x4*)((char*)(ub + (size_t)(SEQ - LR_T) * NLRU + DRNN) + goff[k]) = yv; }
        __syncthreads();
    }
}

constexpr int RT_KSS = 544, RT_VSS = 288, RT_STS = 528;
constexpr int RT_KS = 0, RT_VS = 64 * RT_KSS, RT_ST = RT_VS + 64 * RT_VSS, RT_OS = RT_ST + 128 * RT_STS, RT_SS = RT_OS + 64 * RT_VSS;
static_assert(RT_SS + 1024 + 512 <= LDSCTL_OFF, "retention LDS map");
template <int NJ> __device__ __forceinline__ void ret_st(f32x4 (&sacc)[4], const LAS unsigned char* krd, const bf16x8 (&qf)[8]) {
    bf16x8 fr[2][NJ];
#pragma unroll
    for (int jt = 0; jt < NJ; ++jt) fr[0][jt] = *(const LAS bf16x8*)(krd + jt * 16 * RT_KSS);
    __builtin_amdgcn_sched_group_barrier(0x100, NJ, 0);
#pragma unroll
    for (int s = 0; s < 8; ++s) {
        if (s + 1 < 8) {
#pragma unroll
            for (int jt = 0; jt < NJ; ++jt) fr[(s + 1) & 1][jt] = *(const LAS bf16x8*)(krd + jt * 16 * RT_KSS + (s + 1) * 64);
            __builtin_amdgcn_sched_group_barrier(0x100, NJ, 0); }
#pragma unroll
        for (int jt = 0; jt < NJ; ++jt) sacc[jt] = __builtin_amdgcn_mfma_f32_16x16x32_bf16(fr[s & 1][jt], qf[s], sacc[jt], 0, 0, 0);
        __builtin_amdgcn_sched_group_barrier(0x008, NJ, 0);
    }
}
template <bool DRY> __device__ __forceinline__ void ret_phase(LAS unsigned char* lds, bf16* U, bf16* dry, unsigned long long* gran, int lp, int G, int bid, int tid) {
    constexpr int ABL = DRY ? RET_ABL : 0;
    const int lane = tid & 63, w = __builtin_amdgcn_readfirstlane(tid >> 6), eh = w >> 2, ct = eh ? 3 - (w & 3) : (w & 3), i16 = lane & 15, kg = lane >> 4, q4 = i16 >> 2, p4 = lane & 3;
    LAS unsigned char* kwr = lds + RT_KS + (tid >> 5) * RT_KSS + (tid & 31) * 16;
    LAS unsigned char* vwr = lds + RT_VS + (tid >> 4) * RT_VSS + (tid & 15) * 16;
    LAS unsigned char* ktr = lds + RT_KS + (4 * kg + q4) * RT_KSS + 64 * w + 8 * p4;
    LAS unsigned char* vto = lds + RT_VS + (4 * kg + q4) * RT_VSS + 8 * p4 + 128 * eh;
    LAS unsigned char* krd = lds + RT_KS + i16 * RT_KSS + 16 * kg;
    LAS unsigned char* srd = lds + RT_ST + (64 * eh + i16) * RT_STS + 16 * kg;
    LAS unsigned char* swo = lds + RT_ST + (64 * eh + i16) * RT_STS + 64 * w + 8 * kg;
    LAS unsigned char* owr = lds + RT_OS + (16 * ct + i16) * RT_VSS + (64 * eh + 4 * kg) * 2;
    LAS unsigned char* ord_ = lds + RT_OS + (tid >> 4) * RT_VSS + (tid & 15) * 16;
    asm volatile("" : "+v"(kwr), "+v"(vwr), "+v"(ktr), "+v"(vto), "+v"(krd));
    asm volatile("" : "+v"(srd), "+v"(swo), "+v"(owr), "+v"(ord_));
    const int dvx = 128 - 256 * eh, dsx = (64 - 128 * eh) * RT_STS;
    const unsigned koff = (unsigned)(((tid >> 5) * NRET + (tid & 31) * 8) * 2), voff = (unsigned)(((tid >> 4) * NRET + (tid & 15) * 8) * 2);
    const unsigned qoff = (unsigned)(((16 * ct + i16) * NRET + 8 * kg) * 2);
    const unsigned goffl = (unsigned)(((16 * ct + i16) * NRET + 64 * eh + 4 * kg) * 2);
    const int grow = tid >> 3, gk = tid & 7;
    const int cdiag = 16 * ct + i16 - 4 * kg;
    for (int unit = bid; unit < BATCH * RH * 4; unit += G) {
        const int b = unit >> 4, h = (unit >> 2) & 3, es = unit & 3;
        const float lg = log2f(1.0f - exp2f(-5.0f - (float)h)), g64 = exp2f(64.0f * lg);
        bf16* base = U + (size_t)b * SEQ * NRET;
        const __amdgpu_buffer_rsrc_t rs = __builtin_amdgcn_make_buffer_rsrc(base, 0, SEQ * NRET * 2, 0x00020000);
        const int qcol = h * QKH * 2, kcol = (QKD + h * QKH) * 2, vcol = (2 * QKD + h * VH + es * 128) * 2, gcol = (2 * QKD + VD + h * VH + es * 128) * 2;
        constexpr int ROWB = NRET * 2;
        unsigned long long* gpub_u = gran + (size_t)unit * 4 * 128;
        const unsigned long long* gpoll_u = gran + (size_t)(unit & ~3) * 4 * 128;
        const unsigned gpl = (unsigned)(((gk >> 1) * 4 * 128 + grow * 2 + (gk & 1)) * 8);
        const unsigned tagbase = (DRY ? 1024u : 0u) + (unsigned)lp * 64u + 1u;
        for (int i = tid; i < (128 * RT_STS) / 16; i += 512) *(LAS u32x4*)(lds + RT_ST + i * 16) = (u32x4){0u, 0u, 0u, 0u};
        f32x4 sto[2][4], stx[2][4];
#pragma unroll
        for (int a = 0; a < 2; ++a)
#pragma unroll
            for (int e = 0; e < 4; ++e) { sto[a][e] = (f32x4){0.f, 0.f, 0.f, 0.f}; stx[a][e] = (f32x4){0.f, 0.f, 0.f, 0.f}; }
        u32x4 pk[4], pv[2]; bf16x8 qf[8];
        u32x2 oprev[4];
#pragma unroll
        for (int e4 = 0; e4 < 4; ++e4) oprev[e4] = (u32x2){0u, 0u};
#pragma unroll
        for (int k = 0; k < 4; ++k) pk[k] = __builtin_amdgcn_raw_buffer_load_b128(rs, koff, kcol + 16 * k * ROWB, 0);
#pragma unroll
        for (int k = 0; k < 2; ++k) pv[k] = __builtin_amdgcn_raw_buffer_load_b128(rs, voff, vcol + 32 * k * ROWB, 0);
#pragma unroll
        for (int s = 0; s < 8; ++s) qf[s] = __builtin_bit_cast(bf16x8, __builtin_amdgcn_raw_buffer_load_b128(rs, qoff, qcol + 64 * s, 0));
        __syncthreads();
#pragma unroll 1
        for (int step = 0; step <= SEQ / 64; ++step) {
            const bool live = step < SEQ / 64;
            const int t0 = live ? step * 64 : SEQ - 64;
            const int tp = step > 0 ? (step - 1) * 64 : 0;
#pragma unroll
            for (int k = 0; k < 4; ++k) *(LAS u32x4*)(kwr + k * 16 * RT_KSS) = pk[k];
#pragma unroll
            for (int k = 0; k < 2; ++k) *(LAS u32x4*)(vwr + k * 32 * RT_VSS) = pv[k];
            const int tn = (step + 1 < SEQ / 64) ? t0 + 64 : t0;
#pragma unroll
            for (int k = 0; k < 4; ++k) pk[k] = __builtin_amdgcn_raw_buffer_load_b128(rs, koff, kcol + (tn + 16 * k) * ROWB, 0);
#pragma unroll
            for (int k = 0; k < 2; ++k) pv[k] = __builtin_amdgcn_raw_buffer_load_b128(rs, voff, vcol + (tn + 32 * k) * ROWB, 0);
            __syncthreads();
            if (step >= 2) {
#pragma unroll
                for (int k = 0; k < 2; ++k) { const u32x4 ov = *(const LAS u32x4*)(ord_ + k * 32 * RT_VSS);
                    if (DRY) *(u32x4*)(dry + ((size_t)b * SEQ + (step - 2) * 64 + 32 * k + (tid >> 4)) * DM + (h * 4 + es) * 64 + (tid & 7) * 8) = ov;
                    else __builtin_amdgcn_raw_buffer_store_b128(ov, rs, voff, gcol + ((step - 2) * 64 + 32 * k) * ROWB, 0); } }
            unsigned long long gr = (DRY && (RET_ABL & 4)) ? 0ull : __hip_atomic_load((const unsigned long long*)((const char*)(gpoll_u + ((step + 3) & 3) * 128) + gpl), __ATOMIC_RELAXED, __HIP_MEMORY_SCOPE_AGENT);
            u32x2 g4[4];
#pragma unroll
            for (int e4 = 0; e4 < 4; ++e4) g4[e4] = (DRY && (RET_ABL & 2)) ? (u32x2){0u, 0u} : __builtin_amdgcn_raw_buffer_load_b64(rs, goffl, gcol + tp * ROWB + 32 * e4, 0);
            f32x4 sacc[4];
#pragma unroll
            for (int jt = 0; jt < 4; ++jt) sacc[jt] = (f32x4){0.f, 0.f, 0.f, 0.f};
            if (ct == 0) ret_st<1>(sacc, krd, qf); else if (ct == 1) ret_st<2>(sacc, krd, qf); else if (ct == 2) ret_st<3>(sacc, krd, qf); else ret_st<4>(sacc, krd, qf);
            __builtin_amdgcn_sched_barrier(0);
            unsigned pw[2][4];
            int cd = cdiag; asm volatile("" : "+v"(cd));
#pragma unroll
            for (int jt = 0; jt < 4; ++jt) {
                const float m0 = (16 * jt + 0 <= cd) ? sacc[jt][0] : 0.f, m1 = (16 * jt + 1 <= cd) ? sacc[jt][1] : 0.f, m2 = (16 * jt + 2 <= cd) ? sacc[jt][2] : 0.f, m3 = (16 * jt + 3 <= cd) ? sacc[jt][3] : 0.f;
                pw[jt >> 1][2 * (jt & 1)] = pk2(m0, m1); pw[jt >> 1][2 * (jt & 1) + 1] = pk2(m2, m3); }
            f32x4 oacc[4];
#pragma unroll
            for (int e4 = 0; e4 < 4; ++e4) oacc[e4] = (f32x4){0.f, 0.f, 0.f, 0.f};
#pragma unroll
            for (int ks = 0; ks < 2; ++ks) {
                const bf16x8 pa = __builtin_bit_cast(bf16x8, (u32x4){pw[ks][0], pw[ks][1], pw[ks][2], pw[ks][3]});
                bf16x8 af[2], bfr[8];
#pragma unroll
                for (int a = 0; a < 2; ++a) { const LAS unsigned char* p = ktr + ks * 32 * RT_KSS + a * 32; af[a] = cat8(ds_tr(p), ds_tr(p + 16 * RT_KSS)); }
                { const LAS unsigned char* p = vto + ks * 32 * RT_VSS; bfr[0] = cat8(ds_tr(p), ds_tr(p + 16 * RT_VSS)); }
                __builtin_amdgcn_sched_group_barrier(0x100, 6, 0);
#pragma unroll
                for (int i = 0; i < 8; ++i) {
                    if (i + 1 < 8) { const LAS unsigned char* p = vto + ((i + 1 < 4) ? 0 : dvx) + ks * 32 * RT_VSS + ((i + 1) & 3) * 32; bfr[i + 1] = cat8(ds_tr(p), ds_tr(p + 16 * RT_VSS)); }
                    if (i < 4) {
                        sto[0][i] = __builtin_amdgcn_mfma_f32_16x16x32_bf16(af[0], bfr[i], sto[0][i], 0, 0, 0);
                        sto[1][i] = __builtin_amdgcn_mfma_f32_16x16x32_bf16(af[1], bfr[i], sto[1][i], 0, 0, 0);
                        oacc[i] = __builtin_amdgcn_mfma_f32_16x16x32_bf16(bfr[i], pa, oacc[i], 0, 0, 0);
                    } else {
                        stx[0][i - 4] = __builtin_amdgcn_mfma_f32_16x16x32_bf16(af[0], bfr[i], stx[0][i - 4], 0, 0, 0);
                        stx[1][i - 4] = __builtin_amdgcn_mfma_f32_16x16x32_bf16(af[1], bfr[i], stx[1][i - 4], 0, 0, 0);
                    }
                    if (i + 1 < 8) __builtin_amdgcn_sched_group_barrier(0x100, 2, 0);
                    if (i < 4) __builtin_amdgcn_sched_group_barrier(0x008, 3, 0); else __builtin_amdgcn_sched_group_barrier(0x008, 2, 0);
                }
            }
            __builtin_amdgcn_sched_barrier(0);
            {
                bf16x8 fr[2][4];
#pragma unroll
                for (int e4 = 0; e4 < 4; ++e4) fr[0][e4] = *(const LAS bf16x8*)(srd + e4 * 16 * RT_STS);
                __builtin_amdgcn_sched_group_barrier(0x100, 4, 0);
#pragma unroll
                for (int s = 0; s < 8; ++s) {
                    if (s + 1 < 8) {
#pragma unroll
                        for (int e4 = 0; e4 < 4; ++e4) fr[(s + 1) & 1][e4] = *(const LAS bf16x8*)(srd + e4 * 16 * RT_STS + (s + 1) * 64);
                        __builtin_amdgcn_sched_group_barrier(0x100, 4, 0); }
#pragma unroll
                    for (int e4 = 0; e4 < 4; ++e4) oacc[e4] = __builtin_amdgcn_mfma_f32_16x16x32_bf16(fr[s & 1][e4], qf[s], oacc[e4], 0, 0, 0);
                    __builtin_amdgcn_sched_group_barrier(0x008, 4, 0);
                }
            }
            __builtin_amdgcn_sched_barrier(0);
#pragma unroll
            for (int s = 0; s < 8; ++s) qf[s] = __builtin_bit_cast(bf16x8, __builtin_amdgcn_raw_buffer_load_b128(rs, qoff, qcol + tn * ROWB + 64 * s, 0));
            { float s1 = 0.f, s2 = 0.f;
#pragma unroll
              for (int e4 = 0; e4 < 4; ++e4) { const f32x4 o = oacc[e4]; s1 += (o[0] + o[1]) + (o[2] + o[3]); s2 += (o[0] * o[0] + o[1] * o[1]) + (o[2] * o[2] + o[3] * o[3]); }
              s1 += __shfl_xor(s1, 16); s2 += __shfl_xor(s2, 16); s1 += __shfl_xor(s1, 32); s2 += __shfl_xor(s2, 32);
              if (kg == 0) *(LAS f32x2*)(lds + RT_SS + (eh * 64 + 16 * ct + i16) * 8) = (f32x2){s1, s2}; }
            { const unsigned want = tagbase + (unsigned)(step - 1);
              if (step > 0 && !(DRY && (RET_ABL & 1))) { unsigned spins = 0;
                  while (!__all((unsigned)(gr >> 32) == want)) { __builtin_amdgcn_s_sleep(1); if (++spins > (1u << 16)) break;
                      gr = __hip_atomic_load((const unsigned long long*)((const char*)(gpoll_u + ((step + 3) & 3) * 128) + gpl), __ATOMIC_RELAXED, __HIP_MEMORY_SCOPE_AGENT); } }
              float v = __uint_as_float((unsigned)gr);
              v += __shfl_xor(v, 2); v += __shfl_xor(v, 4);
              const float v2 = __shfl_xor(v, 1);
              if (gk == 0) { const float mu = v * (1.0f / VH), var = fmaxf(v2 * (1.0f / VH) - mu * mu, 0.f), rstd = 1.0f / sqrtf(var + GN_EPS);
                  *(LAS f32x2*)(lds + RT_SS + 1024 + grow * 8) = (f32x2){rstd, -mu * rstd}; } }
            __syncthreads();
            if (tid < 128 && live && !(DRY && (RET_ABL & 4))) { const float sv = *(const LAS float*)(lds + RT_SS + tid * 4) + *(const LAS float*)(lds + RT_SS + 512 + tid * 4);
                __hip_atomic_store(gpub_u + (step & 3) * 128 + tid, ((unsigned long long)(tagbase + (unsigned)step) << 32) | (unsigned long long)__float_as_uint(sv), __ATOMIC_RELAXED, __HIP_MEMORY_SCOPE_AGENT); }
            if (step > 0 && !(DRY && (RET_ABL & 2))) { const f32x2 nr = *(const LAS f32x2*)(lds + RT_SS + 1024 + (16 * ct + i16) * 8);
#pragma unroll
                for (int e4 = 0; e4 < 4; ++e4) { const u32x2 ow = oprev[e4], gw = g4[e4];
                    const float o0 = bflo(ow.x), o1 = bfhi(ow.x), o2 = bflo(ow.y), o3 = bfhi(ow.y), q0 = bflo(gw.x), q1 = bfhi(gw.x), q2 = bflo(gw.y), q3 = bfhi(gw.y);
                    u32x2 yw; yw.x = pk2(fmaf(o0, nr.x, nr.y) * q0 * sigmoidf_fast(q0), fmaf(o1, nr.x, nr.y) * q1 * sigmoidf_fast(q1));
                    yw.y = pk2(fmaf(o2, nr.x, nr.y) * q2 * sigmoidf_fast(q2), fmaf(o3, nr.x, nr.y) * q3 * sigmoidf_fast(q3));
                    *(LAS u32x2*)(owr + e4 * 32) = yw; } }
#pragma unroll
            for (int e4 = 0; e4 < 4; ++e4) { const f32x4 o = oacc[e4]; oprev[e4].x = pk2(o[0], o[1]); oprev[e4].y = pk2(o[2], o[3]); }
#pragma unroll
            for (int a = 0; a < 2; ++a)
#pragma unroll
                for (int e4 = 0; e4 < 4; ++e4) {
                    sto[a][e4] = sto[a][e4] * g64; stx[a][e4] = stx[a][e4] * g64;
                    u32x2 o; o.x = pk2(sto[a][e4][0], sto[a][e4][1]); o.y = pk2(sto[a][e4][2], sto[a][e4][3]); *(LAS u32x2*)(swo + e4 * 16 * RT_STS + a * 32) = o;
                    u32x2 x; x.x = pk2(stx[a][e4][0], stx[a][e4][1]); x.y = pk2(stx[a][e4][2], stx[a][e4][3]); *(LAS u32x2*)(swo + dsx + e4 * 16 * RT_STS + a * 32) = x; }
        }
        __syncthreads();
#pragma unroll
        for (int k = 0; k < 2; ++k) { const u32x4 ov = *(const LAS u32x4*)(ord_ + k * 32 * RT_VSS);
            if (DRY) *(u32x4*)(dry + ((size_t)b * SEQ + (SEQ - 64) + 32 * k + (tid >> 4)) * DM + (h * 4 + es) * 64 + (tid & 7) * 8) = ov;
            else __builtin_amdgcn_raw_buffer_store_b128(ov, rs, voff, gcol + (SEQ - 64 + 32 * k) * ROWB, 0); }
        __syncthreads();
    }
}

template <bool DRY> __device__ __forceinline__ void retfin_phase(bf16* U, bf16* dry, const float* stats, int G, int vcu, int tid) {
    const int lane = tid & 63, wave = __builtin_amdgcn_readfirstlane(tid >> 6);
    const int gw = vcu * NWAVES + wave, NGW = G * NWAVES;
    for (int it = gw; it < M * RH; it += NGW) {
        const int m = it >> 2, h = it & 3;
        const f32x4 sa = *(const f32x4*)(stats + (size_t)it * 8), sb = *(const f32x4*)(stats + (size_t)it * 8 + 4);
        const float s1 = (sa.x + sa.z) + (sb.x + sb.z), s2 = (sa.y + sa.w) + (sb.y + sb.w);
        const float mu = s1 * (1.0f / VH), var = fmaxf(s2 * (1.0f / VH) - mu * mu, 0.f), rstd = 1.0f / sqrtf(var + GN_EPS);
        bf16* rowp = U + (size_t)m * NRET;
        const u32x4 ov = *(const u32x4*)(rowp + 2 * QKD + h * VH + lane * 8);
        u32x4* gp = (u32x4*)(rowp + 2 * QKD + VD + h * VH + lane * 8);
        const u32x4 gv = *gp;
        const unsigned ow[4] = {ov.x, ov.y, ov.z, ov.w}, gw4[4] = {gv.x, gv.y, gv.z, gv.w}; unsigned yw[4];
#pragma unroll
        for (int j = 0; j < 4; ++j) { const float o0 = bflo(ow[j]), o1 = bfhi(ow[j]), g0 = bflo(gw4[j]), g1 = bfhi(gw4[j]);
            yw[j] = pk2((o0 - mu) * rstd * g0 * sigmoidf_fast(g0), (o1 - mu) * rstd * g1 * sigmoidf_fast(g1)); }
        if (DRY) *(u32x4*)(dry + (size_t)m * DM + (h & 1) * 512 + lane * 8) = (u32x4){yw[0], yw[1], yw[2], yw[3]};
        else *gp = (u32x4){yw[0], yw[1], yw[2], yw[3]};
    }
}

__device__ __forceinline__ KArgs pargs() { KArgs p = (KArgs)__builtin_amdgcn_kernarg_segment_ptr(); asm volatile("" : "+s"(p)); return p; }
__device__ __forceinline__ int ptid() { int t = threadIdx.x; asm volatile("" : "+v"(t)); return t; }
constexpr int N_PHASES = 17;
__global__ void __launch_bounds__(NWAVES * 64, 2) hybrid_fwd(Args args) {
    extern __shared__ __attribute__((aligned(16))) unsigned char lds_raw[];
    LAS unsigned char* lds = (LAS unsigned char*)lds_raw;
    const int tid = threadIdx.x, G = gridDim.x, bid = blockIdx.x;
    const int vcu = (G % 8 == 0) ? (bid % 8) * (G / 8) + bid / 8 : bid;
    unsigned* ctl = (unsigned*)(pargs()->ws + WS_CTL);
    for (int u = tid; u < (LDS_BYTES - LDSCTL_OFF) / 4; u += NWAVES * 64) ((LAS unsigned*)(lds + LDSCTL_OFF))[u] = 0u;
    __syncthreads();
    volatile LAS unsigned* MISC = (volatile LAS unsigned*)(lds + MISC_OFF);
    XcdBarrier bar; bar.bar = ctl + CW_BAR; bar.x = 0; bar.st = nullptr;
    if (!MK_SPLIT) bar = xcd_barrier_post(ctl + CW_BAR, MISC + 8);
    const int lo = pargs()->ph_lo, hi = pargs()->ph_hi;
#define IN(k) (lo <= (k) && (k) < hi)
#define SEAM(k) do { if (IN(k) && IN((k) + 1)) { if (MK_SPLIT) { if (tid == 0) __hip_atomic_store(ctl + 0, 0xBADBA0u, __ATOMIC_RELAXED, __HIP_MEMORY_SCOPE_AGENT); } else xcd_barrier(bar); } } while (0)


    if (IN(0) && EN(0)) { p0_prologue(lds, pargs(), G, vcu, ptid()); __syncthreads(); }
    SEAM(0);
#pragma unroll 1
    for (int lp = 0; lp < 2; ++lp) {
        const int pb = 1 + 8 * lp;
        if (IN(pb + 0) && EN(1)) {
            KArgs args = pargs(); unsigned char* ws = args->ws; bf16* H = (bf16*)(ws + WS_H); bf16* U = (bf16*)(ws + WS_U);
            pg8::Gemm g{H, (const bf16*)(ws + WS_WLIN) + (size_t)lp * NLRU * DM, M, NLRU, DM, DM}; pg8::StaticOrder S; S.init(M, NLRU, G, bid);
            pg8::EpiPlain E{U, NLRU};
            if (PROBE_DUP & 512) { pg8::EpiNull EN_; pg8::gemm_phase<pg8::EpiNull, pg8::StaticOrder, true, true>(lds, g, S, EN_, ptid()); }
            if (PROBE_DUP & (1 | 32)) pg8::gemm_phase<pg8::EpiPlain, pg8::StaticOrder, PGA, true>(lds, g, S, E, ptid());
            pg8::gemm_phase<pg8::EpiPlain, pg8::StaticOrder, PGA, true>(lds, g, S, E, ptid());
        }
        SEAM(pb + 0);
        if (IN(pb + 1) && EN(2)) {
            KArgs args = pargs(); unsigned char* ws = args->ws; bf16* H = (bf16*)(ws + WS_H); bf16* U = (bf16*)(ws + WS_U);
            const bf16* gwp = (const bf16*)(ws + WS_GATEW) + (size_t)lp * 2 * NGB * BW * BW;
            if (PROBE_DUP & 2) { lru_phase<true>(lds, U, H, gwp, args->in[4] + (size_t)lp * 4 * DRNN, args->in[5] + (size_t)lp * DRNN,
                      args->in[7] + (size_t)lp * DRNN, args->in[9] + (size_t)lp * DRNN, args->in[10] + (size_t)lp * DRNN, G, vcu, ptid()); __syncthreads(); }
            lru_phase<false>(lds, U, H, gwp, args->in[4] + (size_t)lp * 4 * DRNN, args->in[5] + (size_t)lp * DRNN,
                      args->in[7] + (size_t)lp * DRNN, args->in[9] + (size_t)lp * DRNN, args->in[10] + (size_t)lp * DRNN, G, vcu, ptid());
        }
        SEAM(pb + 1);
        if (IN(pb + 2) && EN(3)) {
            KArgs args = pargs(); unsigned char* ws = args->ws; bf16* H = (bf16*)(ws + WS_H); bf16* U = (bf16*)(ws + WS_U);
            pg8::Gemm g{U + DRNN, (const bf16*)(ws + WS_WLOUT) + (size_t)lp * DM * DRNN, M, DM, DRNN, NLRU}; pg8::StaticOrder S; S.init(M, DM, G, bid);
            pg8::EpiPlain E{U, NLRU};
            if (PROBE_DUP & (1 | 64)) pg8::gemm_phase<pg8::EpiPlain, pg8::StaticOrder, PGA, true>(lds, g, S, E, ptid());
            pg8::gemm_phase<pg8::EpiPlain, pg8::StaticOrder, PGA, true>(lds, g, S, E, ptid());
        }
        SEAM(pb + 2);
        if (IN(pb + 3) && EN(4)) {
            KArgs args = pargs(); unsigned char* ws = args->ws; bf16* H = (bf16*)(ws + WS_H); bf16* U = (bf16*)(ws + WS_U); float* dryf = (float*)U; bf16* dryh = U + (size_t)M * DM * 2;
            const int layer = 2 * lp;
            norm_phase(H, (float*)(ws + WS_RMS), U, NLRU, args->in[2] + (size_t)layer * DM, args->out, false, G, vcu, ptid());
        }
        SEAM(pb + 3);
        if (IN(pb + 4) && EN(5)) {
            KArgs args = pargs(); unsigned char* ws = args->ws; bf16* H = (bf16*)(ws + WS_H); bf16* U = (bf16*)(ws + WS_U); const float* rcos = (const float*)(ws + WS_ROPE); const float* rsin = rcos + SEQ * 128;
            pg8::Gemm g{H, (const bf16*)(ws + WS_WRIN) + (size_t)lp * NRET * DM, M, NRET, DM, DM}; pg8::StaticOrder S; S.init(M, NRET, G, bid);
            pg8::EpiRet E{U, NRET, rcos, rsin};
            if (PROBE_DUP & (1 | 128)) pg8::gemm_phase<pg8::EpiRet, pg8::StaticOrder, PGA, true>(lds, g, S, E, ptid());
            pg8::gemm_phase<pg8::EpiRet, pg8::StaticOrder, PGA, true>(lds, g, S, E, ptid());
        }
        SEAM(pb + 4);
        if (IN(pb + 5) && EN(6)) {
            KArgs args = pargs(); unsigned char* ws = args->ws; bf16* H = (bf16*)(ws + WS_H); bf16* U = (bf16*)(ws + WS_U); float* stats = (float*)(ws + WS_STATS);
            if (PROBE_DUP & 4) { ret_phase<true>(lds, U, H, (unsigned long long*)(ws + WS_GRAN), lp, G, vcu, ptid()); __syncthreads(); }
            ret_phase<false>(lds, U, H, (unsigned long long*)(ws + WS_GRAN), lp, G, vcu, ptid());
        }
        SEAM(pb + 5);
        if (IN(pb + 6) && EN(8)) {
            KArgs args = pargs(); unsigned char* ws = args->ws; bf16* H = (bf16*)(ws + WS_H); bf16* U = (bf16*)(ws + WS_U);
            pg8::Gemm g{U + 2 * QKD + VD, (const bf16*)(ws + WS_WROUT) + (size_t)lp * DM * VD, M, DM, VD, NRET}; pg8::StaticOrder S; S.init(M, DM, G, bid);
            pg8::EpiPlain E{U, NRET};
            if (PROBE_DUP & (1 | 256)) pg8::gemm_phase<pg8::EpiPlain, pg8::StaticOrder, PGA, true>(lds, g, S, E, ptid());
            pg8::gemm_phase<pg8::EpiPlain, pg8::StaticOrder, PGA, true>(lds, g, S, E, ptid());
        }
        SEAM(pb + 6);
        if (IN(pb + 7) && EN(4)) {
            KArgs args = pargs(); unsigned char* ws = args->ws; bf16* H = (bf16*)(ws + WS_H); bf16* U = (bf16*)(ws + WS_U); float* dryf = (float*)U; bf16* dryh = U + (size_t)M * DM * 2;
            const int layer = 2 * lp + 1;
            norm_phase(H, (float*)(ws + WS_RMS), U, NRET, args->in[2] + (size_t)layer * DM, args->out, lp == 1, G, vcu, ptid());
        }
        SEAM(pb + 7);
    }
#undef IN
#undef SEAM
}

extern "C" void kernel_launch(void* const* d_in, const int* in_sizes, int n_in, void* d_out, int out_size, void* d_ws, size_t ws_size, hipStream_t stream) {
    static int grid = 0;
    if (grid == 0) {
        if (n_in != 14 || in_sizes[0] != M * DM || out_size != M * DM || ws_size < WS_END) {
            fprintf(stderr, "kernel_launch: unexpected shapes (n_in %d, in0 %d, out %d, ws %zu); nothing launched\n", n_in, n_in > 0 ? in_sizes[0] : -1, out_size, ws_size); grid = -1; return; }
        int dev = 0, cus = 0, per_cu = 0;
        if (hipGetDevice(&dev) != hipSuccess || hipDeviceGetAttribute(&cus, hipDeviceAttributeMultiprocessorCount, dev) != hipSuccess) { fprintf(stderr, "kernel_launch: device query failed\n"); grid = -1; return; }
        if (hipFuncSetAttribute((const void*)hybrid_fwd, hipFuncAttributeMaxDynamicSharedMemorySize, LDS_BYTES) != hipSuccess) { fprintf(stderr, "kernel_launch: hipFuncSetAttribute failed\n"); grid = -1; return; }
        if (hipOccupancyMaxActiveBlocksPerMultiprocessor(&per_cu, (const void*)hybrid_fwd, NWAVES * 64, LDS_BYTES) != hipSuccess || per_cu < 1)
            fprintf(stderr, "kernel_launch: note: occupancy query reports %d workgroups per CU\n", per_cu);
        (void)hipGetLastError();
        grid = cus;
    }
    if (grid < 0) return;
    if (hipMemsetAsync((char*)d_ws + WS_CTL, 0, CTL_ZERO_BYTES, stream) != hipSuccess) { fprintf(stderr, "kernel_launch: memset failed\n"); return; }
    Args a{};
    for (int i = 0; i < 14; ++i) a.in[i] = (const float*)d_in[i];
    a.out = (float*)d_out; a.ws = (unsigned char*)d_ws;
#if MK_SPLIT
    for (int p = 0; p < N_PHASES; ++p) { a.ph_lo = p; a.ph_hi = p + 1; hipLaunchKernelGGL(hybrid_fwd, dim3(grid), dim3(NWAVES * 64), LDS_BYTES, stream, a); }
#else
    a.ph_lo = 0; a.ph_hi = N_PHASES;
    hipLaunchKernelGGL(hybrid_fwd, dim3(grid), dim3(NWAVES * 64), LDS_BYTES, stream, a);
#endif
    const hipError_t le = hipPeekAtLastError();
    if (le != hipSuccess) fprintf(stderr, "kernel_launch: launch failed: %s\n", hipGetErrorName(le));
}
```

```cpp
#include <hip/hip_runtime.h>
#include <cstdio>
#include <cstdint>

#ifndef MK_SPLIT
#define MK_SPLIT 0
#endif
#ifndef PH_MASK
#define PH_MASK 0x1ff
#endif
#define EN(b) ((PH_MASK >> (b)) & 1)
#ifndef RET_ABL
#define RET_ABL 0
#endif
#ifndef LRU_ABL
#define LRU_ABL 0
#endif
#ifndef PGA
#define PGA false
#endif
#ifndef PROBE_DUP
#define PROBE_DUP 0
#endif

#define LAS __attribute__((address_space(3)))
#define GAS __attribute__((address_space(1)))
typedef unsigned short bf16;
typedef short bf16x8 __attribute__((ext_vector_type(8)));
typedef short s16x4 __attribute__((ext_vector_type(4)));
typedef float f32x4 __attribute__((ext_vector_type(4)));
typedef float f32x2 __attribute__((ext_vector_type(2)));
typedef unsigned u32x4 __attribute__((ext_vector_type(4)));
typedef unsigned u32x2 __attribute__((ext_vector_type(2)));
typedef __bf16 bf16x2_t __attribute__((ext_vector_type(2)));

constexpr int BATCH = 16, SEQ = 4096, DM = 1024, M = BATCH * SEQ;
constexpr int DRNN = 1536, NGB = 16, BW = 96, NLRU = 2 * DRNN;
constexpr int RH = 4, QKH = 256, VH = 512, QKD = 1024, VD = 2048, NRET = 2 * QKD + 2 * VD;
constexpr float RMS_EPS = 1e-6f, GN_EPS = 1e-5f;
constexpr float LOG2E = 1.4426950408889634f;

constexpr size_t MiB = 1u << 20;
constexpr size_t WS_CTL = 0, CTL_ZERO_BYTES = 2 * MiB;
constexpr size_t WS_GRAN = 1 * MiB;
constexpr size_t WS_WLIN = 2 * MiB;
constexpr size_t WS_WLOUT = 14 * MiB;
constexpr size_t WS_WRIN = 20 * MiB;
constexpr size_t WS_WROUT = 44 * MiB;
constexpr size_t WS_GATEW = 52 * MiB;
constexpr size_t WS_ROPE = 54 * MiB;
constexpr size_t WS_STATS = 58 * MiB;
constexpr size_t WS_RMS = 66 * MiB;
constexpr size_t WS_H = 128 * MiB;
constexpr size_t WS_U = 256 * MiB;
constexpr size_t WS_END = 1024 * MiB;
constexpr int CW_BAR = 4096;

constexpr int RING_BYTES = 131072;
constexpr int LDSCTL_OFF = 156 * 1024, MISC_OFF = LDSCTL_OFF + 320;
constexpr int LDS_BYTES = 160 * 1024;
constexpr int NWAVES = 8;

__device__ __forceinline__ unsigned pk2(float lo, float hi) { f32x2 v = {lo, hi}; bf16x2_t b = __builtin_convertvector(v, bf16x2_t); return __builtin_bit_cast(unsigned, b); }
__device__ __forceinline__ float bflo(unsigned w) { return __uint_as_float(w << 16); }
__device__ __forceinline__ float bfhi(unsigned w) { return __uint_as_float(w & 0xffff0000u); }
__device__ __forceinline__ float wave_sum(float v) {
#pragma unroll
    for (int o = 1; o < 64; o <<= 1) v += __shfl_xor(v, o);
    return v;
}
__device__ __forceinline__ float sigmoidf_fast(float x) { return __builtin_amdgcn_rcpf(1.0f + __builtin_amdgcn_exp2f(-LOG2E * x)); }
__device__ __forceinline__ s16x4 ds_tr(const LAS unsigned char* p) { return __builtin_bit_cast(s16x4, __builtin_amdgcn_ds_read_tr16_b64_v4i16((LAS s16x4*)p)); }
__device__ __forceinline__ bf16x8 cat8(s16x4 lo, s16x4 hi) { return (bf16x8){lo[0], lo[1], lo[2], lo[3], hi[0], hi[1], hi[2], hi[3]}; }

namespace pg8 {
constexpr int BM = 256, BK = 64, HALF = 128, HTB = HALF * BK * 2, STAGE_BYTES = 8 * HTB, NXCD = 8, WGM = 8;
__host__ __device__ __forceinline__ int lds_byte(int r, int c) { const int st = (r >> 4) * 2 + (c >> 5), rr = r & 15, cc = c & 31, ob = rr * 64 + cc * 2; return st * 1024 + (ob ^ (((ob >> 9) & 1) << 5)); }
__host__ __device__ __forceinline__ void stage_rc(int b, int& R, int& C) { const int st = b / 1024, sb = b % 1024, swz = sb ^ (((sb >> 9) & 1) << 5); R = (st >> 1) * 16 + swz / 64; C = (st & 1) * 32 + (swz % 64) / 2; }
__host__ __device__ __forceinline__ int perm32(int rho) { const int n = rho >> 4, i = rho & 15; return 8 * (i >> 2) + 4 * n + (i & 3); }

struct Unit { int pm, pn; };
struct Gemm { const bf16* A; const bf16* Bt; int M, N, K, lda; };

struct StaticOrder {
    int nM, nN, nwg, G, c;
    __host__ __device__ void init(int M_, int N_, int G_, int c_) { nM = M_ / BM; nN = N_ / BM; nwg = nM * nN; G = G_; c = c_; }
    __host__ __device__ bool next(int i, Unit& u) const {
        const long L = (long)i * G + c; if (L >= nwg) return false;
        int wgid = (int)L; { const int q = nwg / NXCD, r = nwg % NXCD, xcd = wgid % NXCD, off = wgid / NXCD; wgid = (xcd < r ? xcd * (q + 1) : r * (q + 1) + (xcd - r) * q) + off; }
        const int nig = WGM * nN, gid = wgid / nig, fm = gid * WGM, gsz = (nM - fm) < WGM ? (nM - fm) : WGM;
        u.pm = fm + ((wgid % nig) % gsz); u.pn = (wgid % nig) / gsz; return true;
    }
    __device__ __forceinline__ void a_ready(const Unit&) const {}
    __device__ __forceinline__ void done(const Unit&) const {}
};

__device__ __forceinline__ f32x4 silu4(const f32x4 v) { f32x4 r;
#pragma unroll
    for (int i = 0; i < 4; ++i) r[i] = v[i] * __builtin_amdgcn_rcpf(1.0f + __builtin_amdgcn_exp2f(-LOG2E * v[i]));
    return r; }
struct EpiPlain {
    static constexpr bool PERM = true, AFTER_DRAIN = false;
    bf16* O; int ldc; int silu_pn;
    __device__ __forceinline__ void operator()(const f32x4 (&acc)[2][2][4][2], const Unit& u, int wr, int wc, int fr, int fq) const {
        const int row0 = u.pm * BM + wr * 64 + fr, col0 = u.pn * BM + wc * 32 + 8 * fq;
        const bool act = u.pn >= silu_pn;
#pragma unroll
        for (int ai = 0; ai < 2; ++ai)
#pragma unroll
            for (int m = 0; m < 4; ++m) { bf16* rowp = O + (size_t)(row0 + ai * HALF + m * 16) * ldc + col0;
#pragma unroll
                for (int bj = 0; bj < 2; ++bj) { f32x4 v0 = acc[ai][bj][m][0], v1 = acc[ai][bj][m][1];
                    if (act) { v0 = silu4(v0); v1 = silu4(v1); }
                    u32x4 w; w.x = pk2(v0[0], v0[1]); w.y = pk2(v0[2], v0[3]); w.z = pk2(v1[0], v1[1]); w.w = pk2(v1[2], v1[3]);
                    *(u32x4*)(rowp + bj * HALF) = w; } }
    }
};
struct EpiNull {
    static constexpr bool PERM = true, AFTER_DRAIN = false;
    __device__ __forceinline__ void operator()(const f32x4 (&acc)[2][2][4][2], const Unit&, int, int, int, int) const {
#pragma unroll
        for (int ai = 0; ai < 2; ++ai)
#pragma unroll
            for (int bj = 0; bj < 2; ++bj)
#pragma unroll
                for (int m = 0; m < 4; ++m) asm volatile("" :: "v"(acc[ai][bj][m][0]), "v"(acc[ai][bj][m][1]));
    }
};
struct EpiRet {
    static constexpr bool PERM = true, AFTER_DRAIN = false;
    bf16* O; int ldc; const float* rcos; const float* rsin;
    __device__ __forceinline__ void operator()(const f32x4 (&acc)[2][2][4][2], const Unit& u, int wr, int wc, int fr, int fq) const {
        const int row0 = u.pm * BM + wr * 64 + fr, col0 = u.pn * BM + wc * 32 + 8 * fq;
        if (u.pn < 8) {
            const int h = u.pn & 3; const bool isk = u.pn >= 4;
            const float lg = log2f(1.0f - exp2f(-5.0f - (float)h));
            const float sgn = isk ? -lg : lg, mul = isk ? 0.0625f : 1.0f;
            const int d0 = wc * 32 + 8 * fq;
#pragma unroll
            for (int ai = 0; ai < 2; ++ai)
#pragma unroll
                for (int m = 0; m < 4; ++m) { const int row = row0 + ai * HALF + m * 16, t = row & (SEQ - 1), p = t & 63;
                    const float sc = mul * __builtin_amdgcn_exp2f((float)(p - 63) * sgn);
                    const float* cp = rcos + (size_t)t * 128 + d0; const float* sp = rsin + (size_t)t * 128 + d0;
                    u32x4 wx, wy;
                    { const f32x4 c0 = *(const f32x4*)cp, s0 = *(const f32x4*)sp; const f32x4 a0 = acc[ai][0][m][0], b0 = acc[ai][1][m][0];
                      const f32x4 x0 = (a0 * c0 - b0 * s0) * sc, y0 = (b0 * c0 + a0 * s0) * sc;
                      wx.x = pk2(x0[0], x0[1]); wx.y = pk2(x0[2], x0[3]); wy.x = pk2(y0[0], y0[1]); wy.y = pk2(y0[2], y0[3]); }
                    { const f32x4 c1 = *(const f32x4*)(cp + 4), s1 = *(const f32x4*)(sp + 4); const f32x4 a1 = acc[ai][0][m][1], b1 = acc[ai][1][m][1];
                      const f32x4 x1 = (a1 * c1 - b1 * s1) * sc, y1 = (b1 * c1 + a1 * s1) * sc;
                      wx.z = pk2(x1[0], x1[1]); wx.w = pk2(x1[2], x1[3]); wy.z = pk2(y1[0], y1[1]); wy.w = pk2(y1[2], y1[3]); }
                    bf16* rowp = O + (size_t)row * ldc + col0;
                    *(u32x4*)(rowp) = wx; *(u32x4*)(rowp + HALF) = wy;
                    asm volatile("" ::: "memory"); }
        } else {
#pragma unroll
            for (int ai = 0; ai < 2; ++ai)
#pragma unroll
                for (int m = 0; m < 4; ++m) { bf16* rowp = O + (size_t)(row0 + ai * HALF + m * 16) * ldc + col0;
#pragma unroll
                    for (int bj = 0; bj < 2; ++bj) { f32x4 v0 = acc[ai][bj][m][0], v1 = acc[ai][bj][m][1];
                        if (u.pn >= 16) { v0 = silu4(v0); v1 = silu4(v1); }
                        u32x4 w; w.x = pk2(v0[0], v0[1]); w.y = pk2(v0[2], v0[3]); w.z = pk2(v1[0], v1[1]); w.w = pk2(v1[2], v1[3]);
                        *(u32x4*)(rowp + bj * HALF) = w; } }
        }
    }
};

template <class Epi, class Sched, bool ALIGN_EPI = false, bool SP2 = false>
__device__ __forceinline__ void gemm_phase(LAS unsigned char* lds, const Gemm g, const Sched& S, const Epi& E, const int tid) {
    const int wid = __builtin_amdgcn_readfirstlane(tid >> 6), lane = tid & 63, wr = wid >> 2, wc = wid & 3, fr = lane & 15, fq = lane >> 4;
    const int K = g.K, nt = K / BK, lda = g.lda;
    unsigned voffA[2], voffB[2];
#pragma unroll
    for (int i = 0; i < 2; ++i) { int R, C; stage_rc(tid * 16 + i * 8192, R, C); const int Rb = Epi::PERM ? ((R & ~31) + perm32(R & 31)) : R;
        voffA[i] = (unsigned)(R * lda + C) * 2u; voffB[i] = (unsigned)(Rb * K + C) * 2u; }
    const size_t kstep = (size_t)(BK * 2);
    const size_t hstepA = (size_t)HALF * lda * 2, hstepB = (size_t)HALF * K * 2;
    const size_t tstepA = 2 * hstepA, tstepB = 2 * hstepB;
    const unsigned ldsw = (unsigned)wid * 1024u;
    const int aoff = lds_byte(wr * 64 + fr, fq * 8), boff = lds_byte(wc * 32 + fr, fq * 8);
#define PG8_SA(b, h) (((b) * 2 + (h)) * HTB)
#define PG8_SB(b, h) ((4 + (b) * 2 + (h)) * HTB)
#define PG8_STAGE(bufoff, gbase, voff) do { _Pragma("unroll") for (int _i = 0; _i < 2; ++_i) \
        __builtin_amdgcn_global_load_lds((const unsigned*)((const char*)(gbase) + (voff)[_i]), (LAS unsigned*)(lds + (bufoff) + ldsw + _i * 8192), 16, 0, 0); } while (0)
#define PG8_LDA(dst, b, h) do { _Pragma("unroll") for (int m = 0; m < 4; ++m) _Pragma("unroll") for (int k = 0; k < 2; ++k) dst[m][k] = *(const LAS bf16x8*)(lds + PG8_SA(b, h) + aoff + m * 2048 + k * 1024); } while (0)
#define PG8_LDB(dst, b, h) do { _Pragma("unroll") for (int n = 0; n < 2; ++n) _Pragma("unroll") for (int k = 0; k < 2; ++k) dst[n][k] = *(const LAS bf16x8*)(lds + PG8_SB(b, h) + boff + n * 2048 + k * 1024); } while (0)
#define PG8_MMA(ai, bj, At, Bt) do { __builtin_amdgcn_s_setprio(1); _Pragma("unroll") for (int m = 0; m < 4; ++m) _Pragma("unroll") for (int n = 0; n < 2; ++n) _Pragma("unroll") for (int k = 0; k < 2; ++k) \
        acc[ai][bj][m][n] = __builtin_amdgcn_mfma_f32_16x16x32_bf16(Bt[n][k], At[m][k], acc[ai][bj][m][n], 0, 0, 0); __builtin_amdgcn_s_setprio(0); } while (0)
#define PG8_WAIT_V(n) asm volatile("s_waitcnt vmcnt(" #n ")" ::: "memory")
#define PG8_WAIT_L(n) asm volatile("s_waitcnt lgkmcnt(" #n ")" ::: "memory")
#define PG8_BAR __builtin_amdgcn_s_barrier()
#define PG8_SCHED __builtin_amdgcn_sched_barrier(0)
    Unit cur, nxt; int ui = 0;
    if (!S.next(0, cur)) return;
    f32x4 acc[2][2][4][2];
#pragma unroll
    for (int a = 0; a < 2; ++a)
#pragma unroll
        for (int b = 0; b < 2; ++b)
#pragma unroll
            for (int m = 0; m < 4; ++m)
#pragma unroll
                for (int n = 0; n < 2; ++n) acc[a][b][m][n] = (f32x4){0.f, 0.f, 0.f, 0.f};
    bf16x8 At[4][2], B0[2][2], B1[2][2];
    const char* cA = (const char*)g.A + (size_t)cur.pm * tstepA; const char* cB = (const char*)g.Bt + (size_t)cur.pn * tstepB;
    S.a_ready(cur);
    if constexpr (SP2) {
        PG8_STAGE(PG8_SB(0, 0), cB, voffB); PG8_STAGE(PG8_SB(0, 1), cB + hstepB, voffB); PG8_STAGE(PG8_SA(0, 0), cA, voffA); PG8_STAGE(PG8_SA(0, 1), cA + hstepA, voffA);
        if (wr == 1) PG8_BAR;
        PG8_WAIT_V(2); PG8_BAR;
        PG8_STAGE(PG8_SB(1, 0), cB + kstep, voffB); PG8_STAGE(PG8_SA(1, 0), cA + kstep, voffA); PG8_STAGE(PG8_SB(1, 1), cB + hstepB + kstep, voffB);
        PG8_WAIT_V(6); PG8_BAR;
    } else {
        PG8_STAGE(PG8_SB(0, 0), cB, voffB); PG8_STAGE(PG8_SA(0, 0), cA, voffA); PG8_STAGE(PG8_SB(0, 1), cB + hstepB, voffB); PG8_STAGE(PG8_SA(0, 1), cA + hstepA, voffA);
        if (wr == 1) PG8_BAR;
        PG8_WAIT_V(4); PG8_BAR;
        PG8_STAGE(PG8_SB(1, 0), cB + kstep, voffB); PG8_STAGE(PG8_SA(1, 0), cA + kstep, voffA); PG8_STAGE(PG8_SB(1, 1), cB + hstepB + kstep, voffB);
        PG8_WAIT_V(6); PG8_BAR;
    }
    for (;;) {
        const bool has_next = S.next(ui + 1, nxt);
        const char* nA = has_next ? (const char*)g.A + (size_t)nxt.pm * tstepA : cA; const char* nB = has_next ? (const char*)g.Bt + (size_t)nxt.pn * tstepB : cB;
        for (int t = 0; t < nt; t += 2) {
            const bool last = (t == nt - 2);
            const char* a1 = cA + (size_t)(t + 1) * kstep;
            const char* a2 = last ? nA : cA + (size_t)(t + 2) * kstep; const char* b2 = last ? nB : cB + (size_t)(t + 2) * kstep;
            const char* a3 = a2 + kstep; const char* b3 = b2 + kstep;
            if (last && has_next) S.a_ready(nxt);
            if constexpr (SP2) {
            PG8_LDB(B0, 0, 0); PG8_LDB(B1, 0, 1); PG8_SCHED; PG8_LDA(At, 0, 0); PG8_STAGE(PG8_SA(1, 1), a1 + hstepA, voffA);
            PG8_WAIT_V(8); PG8_WAIT_L(0); PG8_BAR; PG8_MMA(0, 0, At, B0); PG8_MMA(0, 1, At, B1); PG8_BAR; PG8_SCHED;
            PG8_LDA(At, 0, 1); PG8_STAGE(PG8_SB(0, 0), b2, voffB); PG8_STAGE(PG8_SB(0, 1), b2 + hstepB, voffB); PG8_STAGE(PG8_SA(0, 0), a2, voffA);
            PG8_WAIT_V(8); PG8_WAIT_L(0); PG8_BAR; PG8_MMA(1, 0, At, B0); PG8_MMA(1, 1, At, B1); PG8_BAR; PG8_SCHED;
            PG8_LDB(B0, 1, 0); PG8_LDB(B1, 1, 1); PG8_SCHED; PG8_LDA(At, 1, 0); PG8_STAGE(PG8_SA(0, 1), a2 + hstepA, voffA);
            PG8_WAIT_V(8); PG8_WAIT_L(0); PG8_BAR; PG8_MMA(0, 0, At, B0); PG8_MMA(0, 1, At, B1); PG8_BAR; PG8_SCHED;
            PG8_LDA(At, 1, 1); PG8_STAGE(PG8_SB(1, 0), b3, voffB); PG8_STAGE(PG8_SB(1, 1), b3 + hstepB, voffB); PG8_STAGE(PG8_SA(1, 0), a3, voffA);
            PG8_WAIT_V(8); PG8_WAIT_L(0); PG8_BAR; PG8_MMA(1, 0, At, B0); PG8_MMA(1, 1, At, B1); PG8_BAR; PG8_SCHED;
            } else {
            PG8_LDB(B0, 0, 0); PG8_SCHED; PG8_LDA(At, 0, 0); PG8_STAGE(PG8_SA(1, 1), a1 + hstepA, voffA);
            PG8_WAIT_L(8); PG8_BAR; PG8_WAIT_L(0); PG8_MMA(0, 0, At, B0); PG8_BAR; PG8_SCHED;
            PG8_LDB(B1, 0, 1); PG8_STAGE(PG8_SB(0, 0), b2, voffB);
            PG8_BAR; PG8_WAIT_L(0); PG8_MMA(0, 1, At, B1); PG8_BAR;
            PG8_LDA(At, 0, 1); PG8_STAGE(PG8_SA(0, 0), a2, voffA);
            PG8_BAR; PG8_WAIT_L(0); PG8_MMA(1, 0, At, B0); PG8_BAR; PG8_SCHED;
            PG8_STAGE(PG8_SB(0, 1), b2 + hstepB, voffB);
            PG8_WAIT_V(6); PG8_BAR; PG8_MMA(1, 1, At, B1); PG8_BAR;
            PG8_LDB(B0, 1, 0); PG8_SCHED; PG8_LDA(At, 1, 0); PG8_STAGE(PG8_SA(0, 1), a2 + hstepA, voffA);
            PG8_WAIT_L(8); PG8_BAR; PG8_WAIT_L(0); PG8_MMA(0, 0, At, B0); PG8_BAR; PG8_SCHED;
            PG8_LDB(B1, 1, 1); PG8_STAGE(PG8_SB(1, 0), b3, voffB);
            PG8_BAR; PG8_WAIT_L(0); PG8_MMA(0, 1, At, B1); PG8_BAR;
            PG8_LDA(At, 1, 1); PG8_STAGE(PG8_SA(1, 0), a3, voffA);
            PG8_BAR; PG8_WAIT_L(0); PG8_MMA(1, 0, At, B0); PG8_BAR; PG8_SCHED;
            PG8_STAGE(PG8_SB(1, 1), b3 + hstepB, voffB);
            PG8_WAIT_V(6); PG8_BAR; PG8_MMA(1, 1, At, B1); PG8_BAR;
            }
        }
        if constexpr (ALIGN_EPI) { if (wr == 0) PG8_BAR; }
        if constexpr (!Epi::AFTER_DRAIN) { E(acc, cur, wr, wc, fr, fq); S.done(cur); }
        if (!has_next) break;
#pragma unroll
        for (int a = 0; a < 2; ++a)
#pragma unroll
            for (int b = 0; b < 2; ++b)
#pragma unroll
                for (int m = 0; m < 4; ++m)
#pragma unroll
                    for (int n = 0; n < 2; ++n) acc[a][b][m][n] = (f32x4){0.f, 0.f, 0.f, 0.f};
        cur = nxt; cA = nA; cB = nB; ++ui;
        if constexpr (ALIGN_EPI) { if (wr == 1) PG8_BAR; }
    }
    PG8_WAIT_V(0);
    if constexpr (!ALIGN_EPI) { if (wr == 0) PG8_BAR; }
    PG8_BAR;
#undef PG8_SA
#undef PG8_SB
#undef PG8_STAGE
#undef PG8_LDA
#undef PG8_LDB
#undef PG8_MMA
#undef PG8_WAIT_V
#undef PG8_WAIT_L
#undef PG8_BAR
#undef PG8_SCHED
}
}

#define XB_TMO      128
#define XB_XCNT(j)  (256  + 64 * (j))
#define XB_XSUB(j)  (1280 + 64 * (j))
#define XB_XGEN(j)  (2304 + 64 * (j))
#define XB_TOP      3328
#define XB_TOPGEN   3392
#define XCD_BAR_WORDS 3456
#define XB_SPIN_CAP (1u << 18)

__device__ __forceinline__ unsigned xb_ld(unsigned* p)              { return __hip_atomic_load(p, __ATOMIC_RELAXED, __HIP_MEMORY_SCOPE_AGENT); }
__device__ __forceinline__ unsigned xb_add(unsigned* p, unsigned v) { return __hip_atomic_fetch_add(p, v, __ATOMIC_RELAXED, __HIP_MEMORY_SCOPE_AGENT); }
__device__ __forceinline__ unsigned xb_xcc_id() { return (unsigned)__builtin_amdgcn_s_getreg((3 << 11) | 20) & 0xFu; }
#define XB_SPIN(cond, bar) do { unsigned _sp = 0; while (cond) { __builtin_amdgcn_s_sleep(1); \
    if ((++_sp & 255u) == 0u) { if (xb_ld(&(bar)[XB_TMO])) break; if (_sp > XB_SPIN_CAP) { atomicAdd(&(bar)[XB_TMO], 1u); break; } } } } while (0)

struct XcdBarrier {
    unsigned* bar; unsigned x;
    volatile LAS unsigned* st;
};
__device__ __forceinline__ XcdBarrier xcd_barrier_post(unsigned* bar, volatile LAS unsigned* st) {
    XcdBarrier b; b.bar = bar; b.x = xb_xcc_id(); b.st = st;
    if (threadIdx.x == 0) (void)xb_add(&bar[XB_XCNT(b.x)], 1u);
    return b;
}
__device__ __forceinline__ void xcd_barrier_complete(unsigned* bar, unsigned x, unsigned& nloc, unsigned& nx) {
    const unsigned G = gridDim.x * gridDim.y * gridDim.z;
    unsigned sum, cnt, mine, sp = 0u;
    for (;;) {
        sum = 0u; cnt = 0u; mine = 0u;
#pragma unroll
        for (unsigned j = 0; j < 16; ++j) { const unsigned c = xb_ld(&bar[XB_XCNT(j)]); sum += c; cnt += (c > 0u) ? 1u : 0u; mine = (j == x) ? c : mine; }
        if (sum == G) break;
        __builtin_amdgcn_s_sleep(1);
        if ((++sp & 255u) == 0u) { if (xb_ld(&bar[XB_TMO])) break; if (sp > XB_SPIN_CAP) { atomicAdd(&bar[XB_TMO], 1u); break; } }
    }
    nloc = mine > 0u ? mine : 1u; nx = cnt > 0u ? cnt : 1u;
}
__device__ __forceinline__ void xcd_barrier(const XcdBarrier& b) {
    asm volatile("s_waitcnt vmcnt(0)" ::: "memory");
    __syncthreads();
    if (threadIdx.x == 0) {
        unsigned* bar = b.bar;
        __builtin_amdgcn_s_waitcnt(0);
        unsigned nloc = b.st[0], nx = b.st[1];
        if (nloc == 0u) { xcd_barrier_complete(bar, b.x, nloc, nx); b.st[0] = nloc; b.st[1] = nx; }
        const unsigned old = xb_add(&bar[XB_XSUB(b.x)], 1u);
        const unsigned gen = old / nloc;
        if (old + 1u == (gen + 1u) * nloc) {
            __builtin_amdgcn_fence(__ATOMIC_RELEASE, "agent");
            asm volatile("s_waitcnt vmcnt(0)" ::: "memory");
            const unsigned og = xb_add(&bar[XB_TOP], 1u);
            const unsigned tg = og / nx;
            if (og + 1u == (tg + 1u) * nx) xb_add(&bar[XB_TOPGEN], 1u);
            else XB_SPIN(xb_ld(&bar[XB_TOPGEN]) == tg, bar);
            __builtin_amdgcn_fence(__ATOMIC_ACQUIRE, "agent");
            xb_add(&bar[XB_XGEN(b.x)], 1u);
            asm volatile("s_waitcnt vmcnt(0)" ::: "memory");
        } else {
            XB_SPIN(xb_ld(&bar[XB_XGEN(b.x)]) == gen, bar);
            __builtin_amdgcn_fence(__ATOMIC_ACQUIRE, "agent");
            asm volatile("s_waitcnt vmcnt(0)" ::: "memory");
        }
    }
    __syncthreads();
}

__device__ __forceinline__ void p0_transpose_item(const float* W, int K, int N, bf16* WT, LAS float* scr, int item, int lane, const float* gain) {
    const int nblk = N / 32, kb = item / nblk, nb = item % nblk, k0 = 64 * kb, n0 = 32 * nb;
#pragma unroll 8
    for (int i = 0; i < 32; ++i) { const int kk = 2 * i + (lane >> 5); scr[kk * 33 + (lane & 31)] = W[(size_t)(k0 + kk) * N + n0 + (lane & 31)] * (gain ? gain[k0 + kk] : 1.0f); }
    asm volatile("s_waitcnt lgkmcnt(0)" ::: "memory");
    const int c = lane & 7;
#pragma unroll
    for (int j = 0; j < 4; ++j) { const int n = (lane >> 3) + 8 * j; const LAS float* s = scr + (8 * c) * 33 + n;
        u32x4 o; o.x = pk2(s[0 * 33], s[1 * 33]); o.y = pk2(s[2 * 33], s[3 * 33]); o.z = pk2(s[4 * 33], s[5 * 33]); o.w = pk2(s[6 * 33], s[7 * 33]);
        *(u32x4*)(WT + (size_t)(n0 + n) * K + k0 + 8 * c) = o; }
    asm volatile("s_waitcnt lgkmcnt(0)" ::: "memory");
}
__device__ __forceinline__ void sincos_d(double x, double& s, double& c) {
    const double TWO_OVER_PI = 0.63661977236758134308, PIO2_HI = 1.57079632679489655800, PIO2_LO = 6.12323399573676603587e-17;
    const double kq = __builtin_rint(x * TWO_OVER_PI); const int q = (int)kq;
    const double r = (x - kq * PIO2_HI) - kq * PIO2_LO, r2 = r * r;
    double sp = -1.0 / 1307674368000.0; sp = sp * r2 + 1.0 / 6227020800.0; sp = sp * r2 - 1.0 / 39916800.0; sp = sp * r2 + 1.0 / 362880.0; sp = sp * r2 - 1.0 / 5040.0; sp = sp * r2 + 1.0 / 120.0; sp = sp * r2 - 1.0 / 6.0;
    const double sr = r + r * r2 * sp;
    double cp = 1.0 / 20922789888000.0; cp = cp * r2 - 1.0 / 87178291200.0; cp = cp * r2 + 1.0 / 479001600.0; cp = cp * r2 - 1.0 / 3628800.0; cp = cp * r2 + 1.0 / 40320.0; cp = cp * r2 - 1.0 / 720.0; cp = cp * r2 + 1.0 / 24.0; cp = cp * r2 - 0.5;
    const double cr = 1.0 + r2 * cp;
    const bool swp = (q & 1) != 0; const double s0 = swp ? cr : sr, c0 = swp ? sr : cr;
    s = (q & 2) ? -s0 : s0; c = ((q + 1) & 2) ? -c0 : c0;
}

struct Args { const float* in[14]; float* out; unsigned char* ws; int ph_lo, ph_hi; };
typedef const __attribute__((address_space(4))) Args* KArgs;

__device__ __forceinline__ void rms_row_to_bf16(const float* xrow, bf16* orow, float* rms, int lane) {
    const f32x4* xr = (const f32x4*)xrow + lane; f32x4 v[4]; float s = 0.f;
#pragma unroll
    for (int j = 0; j < 4; ++j) { v[j] = xr[64 * j]; s += (v[j].x * v[j].x + v[j].y * v[j].y) + (v[j].z * v[j].z + v[j].w * v[j].w); }
    const float ms = wave_sum(s) * (1.0f / DM) + RMS_EPS, rinv = 1.0f / sqrtf(ms);
    if (lane == 0) *rms = sqrtf(ms);
    u32x2* o8 = (u32x2*)orow + lane;
#pragma unroll
    for (int j = 0; j < 4; ++j) { u32x2 w; w.x = pk2(v[j].x * rinv, v[j].y * rinv); w.y = pk2(v[j].z * rinv, v[j].w * rinv); o8[64 * j] = w; }
}

__device__ __forceinline__ void p0_prologue(LAS unsigned char* lds, KArgs ap, int G, int vcu, int tid) {
    const int lane = tid & 63, wave = __builtin_amdgcn_readfirstlane(tid >> 6);
    unsigned char* ws = ap->ws;
    LAS float* scr = (LAS float*)(lds + wave * 16384);
    const int gw = vcu * NWAVES + wave, NGW = G * NWAVES;
    constexpr int I_LIN = (DM / 64) * (NLRU / 32), I_LOUT = (DRNN / 64) * (DM / 32), I_RIN = (DM / 64) * (NRET / 32), I_ROUT = (VD / 64) * (DM / 32);
    constexpr int I_PER = I_LIN + I_LOUT + I_RIN + I_ROUT, NITEMS = 2 * I_PER;
    for (int it = gw; it < NITEMS; it += NGW) {
        const int j = it / I_PER; int r = it % I_PER;
        if (r < I_LIN) { p0_transpose_item(ap->in[3] + (size_t)j * DM * NLRU, DM, NLRU, (bf16*)(ws + WS_WLIN) + (size_t)j * NLRU * DM, scr, r, lane, ap->in[1] + (size_t)(2 * j) * DM); continue; } r -= I_LIN;
        if (r < I_LOUT) { p0_transpose_item(ap->in[11] + (size_t)j * DRNN * DM, DRNN, DM, (bf16*)(ws + WS_WLOUT) + (size_t)j * DM * DRNN, scr, r, lane, nullptr); continue; } r -= I_LOUT;
        if (r < I_RIN) { p0_transpose_item(ap->in[12] + (size_t)j * DM * NRET, DM, NRET, (bf16*)(ws + WS_WRIN) + (size_t)j * NRET * DM, scr, r, lane, ap->in[1] + (size_t)(2 * j + 1) * DM); continue; } r -= I_RIN;
        p0_transpose_item(ap->in[13] + (size_t)j * VD * DM, VD, DM, (bf16*)(ws + WS_WROUT) + (size_t)j * DM * VD, scr, r, lane, nullptr);
    }
    const int gt = vcu * (NWAVES * 64) + tid, NGT = G * NWAVES * 64;
    { bf16* gw_t = (bf16*)(ws + WS_GATEW);
      for (int o = gt; o < 2 * 2 * NGB * BW * BW; o += NGT) {
          const int cin = o % BW, cout = (o / BW) % BW, n = (o / (BW * BW)) % NGB, mat = (o / (NGB * BW * BW)) % 2, j = o / (2 * NGB * BW * BW);
          const float* src = (mat ? ap->in[8] : ap->in[6]) + (size_t)j * NGB * BW * BW + (size_t)n * BW * BW + cin * BW + cout;
          gw_t[o] = (bf16)(pk2(*src * (-LOG2E), 0.f) & 0xffffu); } }
    { float* rc = (float*)(ws + WS_ROPE); float* rs = rc + SEQ * 128;
      for (int o = gt; o < SEQ * 128; o += NGT) {
          const int i = o & 127, t = o >> 7;
          double f = 1.0, bpow = 0.93057204092969897;
          int e = i; while (e) { if (e & 1) f *= bpow; bpow *= bpow; e >>= 1; }
          const double ang = (double)t * f;
          const double TWO_PI_HI = 6.28318530717958623200, TWO_PI_LO = 2.44929359829470641435e-16;
          const double k = __builtin_rint(ang * 0.15915494309189533577);
          const double x = (ang - k * TWO_PI_HI) - k * TWO_PI_LO;
          double s, c; sincos_d(x, s, c);
          rc[o] = (float)c; rs[o] = (float)s; } }
    for (int m = gw; m < M; m += NGW) rms_row_to_bf16(ap->in[0] + (size_t)m * DM, (bf16*)(ws + WS_H) + (size_t)m * DM, (float*)(ws + WS_RMS) + m, lane);
}

__device__ __forceinline__ void norm_phase(bf16* XN, float* RMS, const bf16* O, int ldo, const float* gpost, float* out, bool last, int G, int vcu, int tid) {
    const int lane = tid & 63, wave = __builtin_amdgcn_readfirstlane(tid >> 6);
    const int gw = vcu * NWAVES + wave, NGW = G * NWAVES;
    f32x4 gp[4];
#pragma unroll
    for (int j = 0; j < 4; ++j) gp[j] = ((const f32x4*)gpost)[lane + 64 * j];
    for (int m = gw; m < M; m += NGW) {
        const u32x2* orow = (const u32x2*)(O + (size_t)m * ldo) + lane; u32x2* xrow = (u32x2*)(XN + (size_t)m * DM) + lane;
        const float rms = RMS[m];
        f32x4 o[4], x[4]; float s = 0.f;
#pragma unroll
        for (int j = 0; j < 4; ++j) { const u32x2 w = orow[64 * j], xw = xrow[64 * j]; o[j] = (f32x4){bflo(w.x), bfhi(w.x), bflo(w.y), bfhi(w.y)}; x[j] = (f32x4){bflo(xw.x), bfhi(xw.x), bflo(xw.y), bfhi(xw.y)};
            s += (o[j].x * o[j].x + o[j].y * o[j].y) + (o[j].z * o[j].z + o[j].w * o[j].w); }
        const float rinv = 1.0f / sqrtf(wave_sum(s) * (1.0f / DM) + RMS_EPS);
        float s2 = 0.f;
#pragma unroll
        for (int j = 0; j < 4; ++j) { x[j] = x[j] * rms + o[j] * rinv * gp[j]; s2 += (x[j].x * x[j].x + x[j].y * x[j].y) + (x[j].z * x[j].z + x[j].w * x[j].w); }
        if (last) { f32x4* outr = (f32x4*)(out + (size_t)m * DM) + lane;
#pragma unroll
            for (int j = 0; j < 4; ++j) outr[64 * j] = x[j];
        } else {
            const float ms = wave_sum(s2) * (1.0f / DM) + RMS_EPS, rinv2 = 1.0f / sqrtf(ms);
            if (lane == 0) RMS[m] = sqrtf(ms);
#pragma unroll
            for (int j = 0; j < 4; ++j) { const f32x4 hv = x[j] * rinv2; u32x2 w; w.x = pk2(hv.x, hv.y); w.y = pk2(hv.z, hv.w); xrow[64 * j] = w; }
        }
    }
}

constexpr int LR_T = 128, LR_RAW = 0, LR_GATE = 25600, LR_XBC = 50176, LR_XBS = 208, LR_WT = 76800, LR_WTS = 208, LR_WTM = 96 * LR_WTS, LR_TOT = LR_WT + 2 * LR_WTM, LR_HP = LR_TOT + 8 * 96 * 8, LR_YT = LR_HP + 768, LR_CW = LR_YT + 128 * 192;
static_assert(LR_CW + 12 * 160 <= LDSCTL_OFF, "LRU LDS map");
template <bool DRY> __device__ __forceinline__ void lru_phase(LAS unsigned char* lds, bf16* U, bf16* dry, const bf16* gatew  , const float* conv_w, const float* conv_b,
                                          const float* b_a, const float* b_x, const float* lam, int G, int bid, int tid) {
    constexpr int ABL = DRY ? LRU_ABL : 0;
    const int lane = tid & 63, w = __builtin_amdgcn_readfirstlane(tid >> 6), i16 = lane & 15, kg = lane >> 4;
    const int cch = tid % 12, ctr = tid / 12; const bool stg = tid < 504;
    unsigned goff[3]; LAS unsigned char* rawp[3]; LAS unsigned char* gatp[3];
#pragma unroll
    for (int k = 0; k < 3; ++k) { const int q = tid + 512 * k, rr = q / 12, ch = q % 12; goff[k] = (unsigned)((rr * NLRU + ch * 8) * 2);
        rawp[k] = lds + LR_RAW + (rr + 3) * 192 + ch * 16; gatp[k] = lds + LR_GATE + rr * 192 + ch * 16; }
    asm volatile("" : "+v"(goff[0]), "+v"(goff[1]), "+v"(goff[2]), "+v"(rawp[0]), "+v"(rawp[1]), "+v"(rawp[2]), "+v"(gatp[0]), "+v"(gatp[1]), "+v"(gatp[2]));
    LAS unsigned char* halo = lds + LR_RAW + (tid / 12) * 192 + (tid % 12) * 16;
    LAS unsigned char* rawc = lds + LR_RAW + ctr * 192 + cch * 16;
    LAS unsigned char* xbwp = lds + LR_XBC + ctr * LR_XBS + cch * 16;
    LAS unsigned char* xard = lds + LR_XBC + (16 * w + i16) * LR_XBS + 16 * kg;
    LAS unsigned char* wtrd = lds + LR_WT + i16 * LR_WTS + 16 * kg;
    LAS unsigned char* xbel = lds + LR_XBC + (16 * w + 4 * kg) * LR_XBS + i16 * 2;
    LAS unsigned char* gtel = lds + LR_GATE + (16 * w + 4 * kg) * 192 + i16 * 2;
    LAS unsigned char* totw = lds + LR_TOT + (w * 96 + i16) * 8;
    LAS unsigned char* totr = lds + LR_TOT + i16 * 8;
    asm volatile("" : "+v"(halo), "+v"(rawc), "+v"(xbwp), "+v"(xard), "+v"(wtrd));
    asm volatile("" : "+v"(xbel), "+v"(gtel), "+v"(totw), "+v"(totr));
    for (int unit = bid; unit < BATCH * NGB; unit += G) {
        const int b = unit >> 4, n = unit & 15;
        bf16* ub = U + (size_t)b * SEQ * NLRU + n * BW;
        if (tid < 480) { const int c12 = tid / 40, j = tid % 40, k = j >> 3, e = j & 7;
            *(LAS float*)(lds + LR_CW + tid * 4) = (k < 4) ? conv_w[k * DRNN + n * BW + c12 * 8 + e] : conv_b[n * BW + c12 * 8 + e]; }
        float ba6[6], bx6[6], cc6[6];
#pragma unroll
        for (int c6 = 0; c6 < 6; ++c6) { const int c = n * BW + 16 * c6 + i16; ba6[c6] = -LOG2E * b_a[c]; bx6[c6] = -LOG2E * b_x[c]; cc6[c6] = -8.0f * log1pf(expf(-lam[c])) * LOG2E; }
        for (int q = tid; q < 2 * 96 * 12; q += 512) { const int mat = q / 1152, rr = (q % 1152) / 12, ch = q % 12;
            *(LAS u32x4*)(lds + LR_WT + mat * LR_WTM + rr * LR_WTS + ch * 16) = *(const u32x4*)(gatew + (size_t)mat * NGB * BW * BW + ((size_t)n * BW + rr) * BW + ch * 8); }
        if (tid < 192) *(LAS float*)(lds + LR_HP + tid * 4) = 0.f;
        u32x4 pfr[3], pfg[3], hreg = (u32x4){0u, 0u, 0u, 0u};
#pragma unroll
        for (int k = 0; k < 3; ++k) { pfr[k] = *(const u32x4*)((const char*)ub + goff[k]); pfg[k] = *(const u32x4*)((const char*)(ub + DRNN) + goff[k]); }
#pragma unroll 1
        for (int ti = 0; ti < SEQ / LR_T; ++ti) {
            const int t0 = ti * LR_T;
#pragma unroll
            for (int k = 0; k < 3; ++k) { *(LAS u32x4*)rawp[k] = pfr[k]; *(LAS u32x4*)gatp[k] = pfg[k]; }
            if (tid < 36) *(LAS u32x4*)halo = hreg;
            __syncthreads();
            if (ti > 0 && !(ABL & 8)) {
#pragma unroll
                for (int k = 0; k < 3; ++k) { const u32x4 yv = *(const LAS u32x4*)(gatp[k] + (LR_YT - LR_GATE));
                    if (DRY) *(u32x4*)(dry + ((size_t)b * SEQ + t0 - LR_T + (tid + 512 * k) / 12) * DM + n * 64 + (cch & 7) * 8) = yv;
                    else *(u32x4*)((char*)(ub + (size_t)(t0 - LR_T) * NLRU + DRNN) + goff[k]) = yv; } }
            if constexpr (!(ABL & 4)) { const int t1 = (ti + 1 < SEQ / LR_T) ? t0 + LR_T : t0;
#pragma unroll
              for (int k = 0; k < 3; ++k) { pfr[k] = *(const u32x4*)((const char*)(ub + (size_t)t1 * NLRU) + goff[k]); pfg[k] = *(const u32x4*)((const char*)(ub + (size_t)t1 * NLRU + DRNN) + goff[k]); } }
            if (stg && !(ABL & 2)) {
#pragma unroll
                for (int k4 = 0; k4 < 4; ++k4) {
                    if (ctr + 42 * k4 < LR_T) {
                        const LAS f32x4* tp = (const LAS f32x4*)(lds + LR_CW + cch * 160);
                        f32x4 b0 = tp[8], b1 = tp[9];
                        f32x2 acc2[4] = {(f32x2){b0.x, b0.y}, (f32x2){b0.z, b0.w}, (f32x2){b1.x, b1.y}, (f32x2){b1.z, b1.w}};
#pragma unroll
                        for (int k = 0; k < 4; ++k) { const u32x4 rv = *(const LAS u32x4*)(rawc + k4 * 42 * 192 + k * 192); const f32x4 w0 = tp[2 * k], w1 = tp[2 * k + 1];
                            acc2[0] += (f32x2){w0.x, w0.y} * (f32x2){bflo(rv.x), bfhi(rv.x)}; acc2[1] += (f32x2){w0.z, w0.w} * (f32x2){bflo(rv.y), bfhi(rv.y)};
                            acc2[2] += (f32x2){w1.x, w1.y} * (f32x2){bflo(rv.z), bfhi(rv.z)}; acc2[3] += (f32x2){w1.z, w1.w} * (f32x2){bflo(rv.w), bfhi(rv.w)}; }
                        u32x4 o; o.x = pk2(acc2[0].x, acc2[0].y); o.y = pk2(acc2[1].x, acc2[1].y); o.z = pk2(acc2[2].x, acc2[2].y); o.w = pk2(acc2[3].x, acc2[3].y);
                        *(LAS u32x4*)(xbwp + k4 * 42 * LR_XBS) = o; } } }
            __syncthreads();
            if (tid < 36) hreg = *(const LAS u32x4*)(halo + 128 * 192);
            float hloc[6][4], acum[6][4];
            if constexpr (ABL & 1) {
#pragma unroll
                for (int c6 = 0; c6 < 6; ++c6)
#pragma unroll
                    for (int r = 0; r < 4; ++r) { hloc[c6][r] = 0.f; acum[c6][r] = 0.f; } }
            if constexpr (!(ABL & 1)) { bf16x8 xa[3];
#pragma unroll
              for (int s = 0; s < 3; ++s) xa[s] = *(const LAS bf16x8*)(xard + s * 64);
#pragma unroll
              for (int c6 = 0; c6 < 6; ++c6) {
                f32x4 ra = {ba6[c6], ba6[c6], ba6[c6], ba6[c6]}, ri = {bx6[c6], bx6[c6], bx6[c6], bx6[c6]};
#pragma unroll
                for (int s = 0; s < 3; ++s) { const bf16x8 wa = *(const LAS bf16x8*)(wtrd + c6 * 16 * LR_WTS + s * 64), wx = *(const LAS bf16x8*)(wtrd + LR_WTM + c6 * 16 * LR_WTS + s * 64);
                    ra = __builtin_amdgcn_mfma_f32_16x16x32_bf16(xa[s], wa, ra, 0, 0, 0); ri = __builtin_amdgcn_mfma_f32_16x16x32_bf16(xa[s], wx, ri, 0, 0, 0); }
                f32x2 xv[2], er[2], ei[2];
#pragma unroll
                for (int p = 0; p < 2; ++p) {
                    xv[p] = (f32x2){__uint_as_float((unsigned)(*(const LAS unsigned short*)(xbel + (2 * p) * LR_XBS + c6 * 32)) << 16), __uint_as_float((unsigned)(*(const LAS unsigned short*)(xbel + (2 * p + 1) * LR_XBS + c6 * 32)) << 16)};
                    er[p] = (f32x2){__builtin_amdgcn_exp2f(ra[2 * p]), __builtin_amdgcn_exp2f(ra[2 * p + 1])} + 1.0f;
                    ei[p] = (f32x2){__builtin_amdgcn_exp2f(ri[2 * p]), __builtin_amdgcn_exp2f(ri[2 * p + 1])} + 1.0f; }
                f32x2 av2[2], bv2[2];
#pragma unroll
                for (int p = 0; p < 2; ++p) {
                    const f32x2 rr = (f32x2){__builtin_amdgcn_rcpf(er[p].x), __builtin_amdgcn_rcpf(er[p].y)}, ii = (f32x2){__builtin_amdgcn_rcpf(ei[p].x), __builtin_amdgcn_rcpf(ei[p].y)};
                    const f32x2 tt = rr * cc6[c6];
                    av2[p] = (f32x2){__builtin_amdgcn_exp2f(tt.x), __builtin_amdgcn_exp2f(tt.y)};
                    const f32x2 om = 1.0f - av2[p] * av2[p];
                    bv2[p] = (f32x2){__builtin_amdgcn_sqrtf(om.x), __builtin_amdgcn_sqrtf(om.y)} * (ii * xv[p]); }
                float av[4], bv[4];
                { const f32x2 ae = (f32x2){av2[0].x, av2[1].x}, ao = (f32x2){av2[0].y, av2[1].y}, be = (f32x2){bv2[0].x, bv2[1].x}, bo = (f32x2){bv2[0].y, bv2[1].y};
                  const f32x2 b01 = ao * be + bo, a01 = ae * ao;
                  av[0] = ae.x; bv[0] = be.x; av[1] = a01.x; bv[1] = b01.x;
                  const f32x2 a2 = (f32x2){ae.y, a01.y}, b2 = (f32x2){be.y, b01.y};
                  const f32x2 bq = a2 * b01.x + b2, aq = a2 * a01.x;
                  av[2] = aq.x; bv[2] = bq.x; av[3] = aq.y; bv[3] = bq.y; }
                float At = av[3], Bt = bv[3];
                { const float Ap = __shfl_up(At, 16), Bp = __shfl_up(Bt, 16); if (kg >= 1) { Bt = fmaf(At, Bp, Bt); At *= Ap; } }
                { const float Ap = __shfl_up(At, 32), Bp = __shfl_up(Bt, 32); if (kg >= 2) { Bt = fmaf(At, Bp, Bt); At *= Ap; } }
                float Ae = __shfl_up(At, 16), Be = __shfl_up(Bt, 16); if (kg == 0) { Ae = 1.0f; Be = 0.f; }
                { const f32x2 h01 = (f32x2){av[0], av[1]} * Be + (f32x2){bv[0], bv[1]}, h23 = (f32x2){av[2], av[3]} * Be + (f32x2){bv[2], bv[3]};
                  const f32x2 c01 = (f32x2){av[0], av[1]} * Ae, c23 = (f32x2){av[2], av[3]} * Ae;
                  hloc[c6][0] = h01.x; hloc[c6][1] = h01.y; hloc[c6][2] = h23.x; hloc[c6][3] = h23.y; acum[c6][0] = c01.x; acum[c6][1] = c01.y; acum[c6][2] = c23.x; acum[c6][3] = c23.y; }
                if (kg == 3) *(LAS f32x2*)(totw + c6 * 128) = (f32x2){At, Bt};
                if (c6 == 2) __builtin_amdgcn_sched_barrier(0);
              } }
            __syncthreads();
            if constexpr (!(ABL & 1)) { const int hp = (ti & 1) * 384;
#pragma unroll
              for (int c6 = 0; c6 < 6; ++c6) {
                float carry = *(const LAS float*)(lds + LR_HP + hp + (16 * c6 + i16) * 4);
                for (int t = 0; t < w; ++t) { const f32x2 ab = *(const LAS f32x2*)(totr + t * 768 + c6 * 128); carry = fmaf(ab.x, carry, ab.y); }
                if (w == 7 && kg == 0) { const f32x2 ab = *(const LAS f32x2*)(totr + 7 * 768 + c6 * 128); *(LAS float*)(lds + LR_HP + (384 - hp) + (16 * c6 + i16) * 4) = fmaf(ab.x, carry, ab.y); }
#pragma unroll
                for (int p = 0; p < 2; ++p) {
                    LAS unsigned short* gp0 = (LAS unsigned short*)(gtel + (2 * p) * 192 + c6 * 32); LAS unsigned short* gp1 = (LAS unsigned short*)(gtel + (2 * p + 1) * 192 + c6 * 32);
                    const f32x2 gv = (f32x2){__uint_as_float((unsigned)(*gp0) << 16), __uint_as_float((unsigned)(*gp1) << 16)};
                    const f32x2 hv = (f32x2){acum[c6][2 * p], acum[c6][2 * p + 1]} * carry + (f32x2){hloc[c6][2 * p], hloc[c6][2 * p + 1]};
                    const f32x2 yv = hv * gv;
                    const unsigned yw = pk2(yv.x, yv.y);
                    *(LAS unsigned short*)((LAS unsigned char*)gp0 + (LR_YT - LR_GATE)) = (unsigned short)(yw & 0xffffu); *(LAS unsigned short*)((LAS unsigned char*)gp1 + (LR_YT - LR_GATE)) = (unsigned short)(yw >> 16); }
              } }
            __syncthreads();
        }
#pragma unroll
        for (int k = 0; k < 3; ++k) { const u32x4 yv = *(const LAS u32x4*)(gatp[k] + (LR_YT - LR_GATE));
            if (DRY) *(u32x4*)(dry + ((size_t)b * SEQ + SEQ - LR_T + (tid + 512 * k) / 12) * DM + n * 64 + (cch & 7) * 8) = yv;
            else *(u32x4*)((char*)(ub + (size_t)(SEQ - LR_T) * NLRU + DRNN) + goff[k]) = yv; }
        __syncthreads();
    }
}

constexpr int RT_KSS = 544, RT_VSS = 288, RT_STS = 528;
constexpr int RT_KS = 0, RT_VS = 64 * RT_KSS, RT_ST = RT_VS + 64 * RT_VSS, RT_OS = RT_ST + 128 * RT_STS, RT_SS = RT_OS + 64 * RT_VSS;
static_assert(RT_SS + 1024 + 512 <= LDSCTL_OFF, "retention LDS map");
template <int NJ> __device__ __forceinline__ void ret_st(f32x4 (&sacc)[4], const LAS unsigned char* krd, const bf16x8 (&qf)[8]) {
    bf16x8 fr[2][NJ];
#pragma unroll
    for (int jt = 0; jt < NJ; ++jt) fr[0][jt] = *(const LAS bf16x8*)(krd + jt * 16 * RT_KSS);
    __builtin_amdgcn_sched_group_barrier(0x100, NJ, 0);
#pragma unroll
    for (int s = 0; s < 8; ++s) {
        if (s + 1 < 8) {
#pragma unroll
            for (int jt = 0; jt < NJ; ++jt) fr[(s + 1) & 1][jt] = *(const LAS bf16x8*)(krd + jt * 16 * RT_KSS + (s + 1) * 64);
            __builtin_amdgcn_sched_group_barrier(0x100, NJ, 0); }
#pragma unroll
        for (int jt = 0; jt < NJ; ++jt) sacc[jt] = __builtin_amdgcn_mfma_f32_16x16x32_bf16(fr[s & 1][jt], qf[s], sacc[jt], 0, 0, 0);
        __builtin_amdgcn_sched_group_barrier(0x008, NJ, 0);
    }
}
template <bool DRY> __device__ __forceinline__ void ret_phase(LAS unsigned char* lds, bf16* U, bf16* dry, unsigned long long* gran, int lp, int G, int bid, int tid) {
    constexpr int ABL = DRY ? RET_ABL : 0;
    const int lane = tid & 63, w = __builtin_amdgcn_readfirstlane(tid >> 6), eh = w >> 2, ct = eh ? 3 - (w & 3) : (w & 3), i16 = lane & 15, kg = lane >> 4, q4 = i16 >> 2, p4 = lane & 3;
    LAS unsigned char* kwr = lds + RT_KS + (tid >> 5) * RT_KSS + (tid & 31) * 16;
    LAS unsigned char* vwr = lds + RT_VS + (tid >> 4) * RT_VSS + (tid & 15) * 16;
    LAS unsigned char* ktr = lds + RT_KS + (4 * kg + q4) * RT_KSS + 64 * w + 8 * p4;
    LAS unsigned char* vto = lds + RT_VS + (4 * kg + q4) * RT_VSS + 8 * p4 + 128 * eh;
    LAS unsigned char* krd = lds + RT_KS + i16 * RT_KSS + 16 * kg;
    LAS unsigned char* srd = lds + RT_ST + (64 * eh + i16) * RT_STS + 16 * kg;
    LAS unsigned char* swo = lds + RT_ST + (64 * eh + i16) * RT_STS + 64 * w + 8 * kg;
    LAS unsigned char* owr = lds + RT_OS + (16 * ct + i16) * RT_VSS + (64 * eh + 4 * kg) * 2;
    LAS unsigned char* ord_ = lds + RT_OS + (tid >> 4) * RT_VSS + (tid & 15) * 16;
    asm volatile("" : "+v"(kwr), "+v"(vwr), "+v"(ktr), "+v"(vto), "+v"(krd));
    asm volatile("" : "+v"(srd), "+v"(swo), "+v"(owr), "+v"(ord_));
    const int dvx = 128 - 256 * eh, dsx = (64 - 128 * eh) * RT_STS;
    const unsigned koff = (unsigned)(((tid >> 5) * NRET + (tid & 31) * 8) * 2), voff = (unsigned)(((tid >> 4) * NRET + (tid & 15) * 8) * 2);
    const unsigned qoff = (unsigned)(((16 * ct + i16) * NRET + 8 * kg) * 2);
    const unsigned goffl = (unsigned)(((16 * ct + i16) * NRET + 64 * eh + 4 * kg) * 2);
    const int grow = tid >> 3, gk = tid & 7;
    const int cdiag = 16 * ct + i16 - 4 * kg;
    for (int unit = bid; unit < BATCH * RH * 4; unit += G) {
        const int b = unit >> 4, h = (unit >> 2) & 3, es = unit & 3;
        const float lg = log2f(1.0f - exp2f(-5.0f - (float)h)), g64 = exp2f(64.0f * lg);
        bf16* base = U + (size_t)b * SEQ * NRET;
        const __amdgpu_buffer_rsrc_t rs = __builtin_amdgcn_make_buffer_rsrc(base, 0, SEQ * NRET * 2, 0x00020000);
        const int qcol = h * QKH * 2, kcol = (QKD + h * QKH) * 2, vcol = (2 * QKD + h * VH + es * 128) * 2, gcol = (2 * QKD + VD + h * VH + es * 128) * 2;
        constexpr int ROWB = NRET * 2;
        unsigned long long* gpub_u = gran + (size_t)unit * 4 * 128;
        const unsigned long long* gpoll_u = gran + (size_t)(unit & ~3) * 4 * 128;
        const unsigned gpl = (unsigned)(((gk >> 1) * 4 * 128 + grow * 2 + (gk & 1)) * 8);
        const unsigned tagbase = (DRY ? 1024u : 0u) + (unsigned)lp * 64u + 1u;
        for (int i = tid; i < (128 * RT_STS) / 16; i += 512) *(LAS u32x4*)(lds + RT_ST + i * 16) = (u32x4){0u, 0u, 0u, 0u};
        f32x4 sto[2][4], stx[2][4];
#pragma unroll
        for (int a = 0; a < 2; ++a)
#pragma unroll
            for (int e = 0; e < 4; ++e) { sto[a][e] = (f32x4){0.f, 0.f, 0.f, 0.f}; stx[a][e] = (f32x4){0.f, 0.f, 0.f, 0.f}; }
        u32x4 pk[4], pv[2]; bf16x8 qf[8];
        u32x2 oprev[4];
#pragma unroll
        for (int e4 = 0; e4 < 4; ++e4) oprev[e4] = (u32x2){0u, 0u};
#pragma unroll
        for (int k = 0; k < 4; ++k) pk[k] = __builtin_amdgcn_raw_buffer_load_b128(rs, koff, kcol + 16 * k * ROWB, 0);
#pragma unroll
        for (int k = 0; k < 2; ++k) pv[k] = __builtin_amdgcn_raw_buffer_load_b128(rs, voff, vcol + 32 * k * ROWB, 0);
#pragma unroll
        for (int s = 0; s < 8; ++s) qf[s] = __builtin_bit_cast(bf16x8, __builtin_amdgcn_raw_buffer_load_b128(rs, qoff, qcol + 64 * s, 0));
        __syncthreads();
#pragma unroll 1
        for (int step = 0; step <= SEQ / 64; ++step) {
            const bool live = step < SEQ / 64;
            const int t0 = live ? step * 64 : SEQ - 64;
            const int tp = step > 0 ? (step - 1) * 64 : 0;
#pragma unroll
            for (int k = 0; k < 4; ++k) *(LAS u32x4*)(kwr + k * 16 * RT_KSS) = pk[k];
#pragma unroll
            for (int k = 0; k < 2; ++k) *(LAS u32x4*)(vwr + k * 32 * RT_VSS) = pv[k];
            const int tn = (step + 1 < SEQ / 64) ? t0 + 64 : t0;
#pragma unroll
            for (int k = 0; k < 4; ++k) pk[k] = __builtin_amdgcn_raw_buffer_load_b128(rs, koff, kcol + (tn + 16 * k) * ROWB, 0);
#pragma unroll
            for (int k = 0; k < 2; ++k) pv[k] = __builtin_amdgcn_raw_buffer_load_b128(rs, voff, vcol + (tn + 32 * k) * ROWB, 0);
            __syncthreads();
            if (step >= 2) {
#pragma unroll
                for (int k = 0; k < 2; ++k) { const u32x4 ov = *(const LAS u32x4*)(ord_ + k * 32 * RT_VSS);
                    if (DRY) *(u32x4*)(dry + ((size_t)b * SEQ + (step - 2) * 64 + 32 * k + (tid >> 4)) * DM + (h * 4 + es) * 64 + (tid & 7) * 8) = ov;
                    else __builtin_amdgcn_raw_buffer_store_b128(ov, rs, voff, gcol + ((step - 2) * 64 + 32 * k) * ROWB, 0); } }
            unsigned long long gr = (DRY && (RET_ABL & 4)) ? 0ull : __hip_atomic_load((const unsigned long long*)((const char*)(gpoll_u + ((step + 3) & 3) * 128) + gpl), __ATOMIC_RELAXED, __HIP_MEMORY_SCOPE_AGENT);
            u32x2 g4[4];
#pragma unroll
            for (int e4 = 0; e4 < 4; ++e4) g4[e4] = (DRY && (RET_ABL & 2)) ? (u32x2){0u, 0u} : __builtin_amdgcn_raw_buffer_load_b64(rs, goffl, gcol + tp * ROWB + 32 * e4, 0);
            f32x4 sacc[4];
#pragma unroll
            for (int jt = 0; jt < 4; ++jt) sacc[jt] = (f32x4){0.f, 0.f, 0.f, 0.f};
            if (ct == 0) ret_st<1>(sacc, krd, qf); else if (ct == 1) ret_st<2>(sacc, krd, qf); else if (ct == 2) ret_st<3>(sacc, krd, qf); else ret_st<4>(sacc, krd, qf);
            __builtin_amdgcn_sched_barrier(0);
            unsigned pw[2][4];
            int cd = cdiag; asm volatile("" : "+v"(cd));
#pragma unroll
            for (int jt = 0; jt < 4; ++jt) {
                const float m0 = (16 * jt + 0 <= cd) ? sacc[jt][0] : 0.f, m1 = (16 * jt + 1 <= cd) ? sacc[jt][1] : 0.f, m2 = (16 * jt + 2 <= cd) ? sacc[jt][2] : 0.f, m3 = (16 * jt + 3 <= cd) ? sacc[jt][3] : 0.f;
                pw[jt >> 1][2 * (jt & 1)] = pk2(m0, m1); pw[jt >> 1][2 * (jt & 1) + 1] = pk2(m2, m3); }
            f32x4 oacc[4];
#pragma unroll
            for (int e4 = 0; e4 < 4; ++e4) oacc[e4] = (f32x4){0.f, 0.f, 0.f, 0.f};
#pragma unroll
            for (int ks = 0; ks < 2; ++ks) {
                const bf16x8 pa = __builtin_bit_cast(bf16x8, (u32x4){pw[ks][0], pw[ks][1], pw[ks][2], pw[ks][3]});
                bf16x8 af[2], bfr[8];
#pragma unroll
                for (int a = 0; a < 2; ++a) { const LAS unsigned char* p = ktr + ks * 32 * RT_KSS + a * 32; af[a] = cat8(ds_tr(p), ds_tr(p + 16 * RT_KSS)); }
                { const LAS unsigned char* p = vto + ks * 32 * RT_VSS; bfr[0] = cat8(ds_tr(p), ds_tr(p + 16 * RT_VSS)); }
                __builtin_amdgcn_sched_group_barrier(0x100, 6, 0);
#pragma unroll
                for (int i = 0; i < 8; ++i) {
                    if (i + 1 < 8) { const LAS unsigned char* p = vto + ((i + 1 < 4) ? 0 : dvx) + ks * 32 * RT_VSS + ((i + 1) & 3) * 32; bfr[i + 1] = cat8(ds_tr(p), ds_tr(p + 16 * RT_VSS)); }
                    if (i < 4) {
                        sto[0][i] = __builtin_amdgcn_mfma_f32_16x16x32_bf16(af[0], bfr[i], sto[0][i], 0, 0, 0);
                        sto[1][i] = __builtin_amdgcn_mfma_f32_16x16x32_bf16(af[1], bfr[i], sto[1][i], 0, 0, 0);
                        oacc[i] = __builtin_amdgcn_mfma_f32_16x16x32_bf16(bfr[i], pa, oacc[i], 0, 0, 0);
                    } else {
                        stx[0][i - 4] = __builtin_amdgcn_mfma_f32_16x16x32_bf16(af[0], bfr[i], stx[0][i - 4], 0, 0, 0);
                        stx[1][i - 4] = __builtin_amdgcn_mfma_f32_16x16x32_bf16(af[1], bfr[i], stx[1][i - 4], 0, 0, 0);
                    }
                    if (i + 1 < 8) __builtin_amdgcn_sched_group_barrier(0x100, 2, 0);
                    if (i < 4) __builtin_amdgcn_sched_group_barrier(0x008, 3, 0); else __builtin_amdgcn_sched_group_barrier(0x008, 2, 0);
                }
            }
            __builtin_amdgcn_sched_barrier(0);
            {
                bf16x8 fr[2][4];
#pragma unroll
                for (int e4 = 0; e4 < 4; ++e4) fr[0][e4] = *(const LAS bf16x8*)(srd + e4 * 16 * RT_STS);
                __builtin_amdgcn_sched_group_barrier(0x100, 4, 0);
#pragma unroll
                for (int s = 0; s < 8; ++s) {
                    if (s + 1 < 8) {
#pragma unroll
                        for (int e4 = 0; e4 < 4; ++e4) fr[(s + 1) & 1][e4] = *(const LAS bf16x8*)(srd + e4 * 16 * RT_STS + (s + 1) * 64);
                        __builtin_amdgcn_sched_group_barrier(0x100, 4, 0); }
#pragma unroll
                    for (int e4 = 0; e4 < 4; ++e4) oacc[e4] = __builtin_amdgcn_mfma_f32_16x16x32_bf16(fr[s & 1][e4], qf[s], oacc[e4], 0, 0, 0);
                    __builtin_amdgcn_sched_group_barrier(0x008, 4, 0);
                }
            }
            __builtin_amdgcn_sched_barrier(0);
#pragma unroll
            for (int s = 0; s < 8; ++s) qf[s] = __builtin_bit_cast(bf16x8, __builtin_amdgcn_raw_buffer_load_b128(rs, qoff, qcol + tn * ROWB + 64 * s, 0));
            { float s1 = 0.f, s2 = 0.f;
#pragma unroll
              for (int e4 = 0; e4 < 4; ++e4) { const f32x4 o = oacc[e4]; s1 += (o[0] + o[1]) + (o[2] + o[3]); s2 += (o[0] * o[0] + o[1] * o[1]) + (o[2] * o[2] + o[3] * o[3]); }
              s1 += __shfl_xor(s1, 16); s2 += __shfl_xor(s2, 16); s1 += __shfl_xor(s1, 32); s2 += __shfl_xor(s2, 32);
              if (kg == 0) *(LAS f32x2*)(lds + RT_SS + (eh * 64 + 16 * ct + i16) * 8) = (f32x2){s1, s2}; }
            { const unsigned want = tagbase + (unsigned)(step - 1);
              if (step > 0 && !(DRY && (RET_ABL & 1))) { unsigned spins = 0;
                  while (!__all((unsigned)(gr >> 32) == want)) { __builtin_amdgcn_s_sleep(1); if (++spins > (1u << 16)) break;
                      gr = __hip_atomic_load((const unsigned long long*)((const char*)(gpoll_u + ((step + 3) & 3) * 128) + gpl), __ATOMIC_RELAXED, __HIP_MEMORY_SCOPE_AGENT); } }
              float v = __uint_as_float((unsigned)gr);
              v += __shfl_xor(v, 2); v += __shfl_xor(v, 4);
              const float v2 = __shfl_xor(v, 1);
              if (gk == 0) { const float mu = v * (1.0f / VH), var = fmaxf(v2 * (1.0f / VH) - mu * mu, 0.f), rstd = 1.0f / sqrtf(var + GN_EPS);
                  *(LAS f32x2*)(lds + RT_SS + 1024 + grow * 8) = (f32x2){rstd, -mu * rstd}; } }
            __syncthreads();
            if (tid < 128 && live && !(DRY && (RET_ABL & 4))) { const float sv = *(const LAS float*)(lds + RT_SS + tid * 4) + *(const LAS float*)(lds + RT_SS + 512 + tid * 4);
                __hip_atomic_store(gpub_u + (step & 3) * 128 + tid, ((unsigned long long)(tagbase + (unsigned)step) << 32) | (unsigned long long)__float_as_uint(sv), __ATOMIC_RELAXED, __HIP_MEMORY_SCOPE_AGENT); }
            if (step > 0 && !(DRY && (RET_ABL & 2))) { const f32x2 nr = *(const LAS f32x2*)(lds + RT_SS + 1024 + (16 * ct + i16) * 8);
#pragma unroll
                for (int e4 = 0; e4 < 4; ++e4) { const u32x2 ow = oprev[e4], gw = g4[e4];
                    const float o0 = bflo(ow.x), o1 = bfhi(ow.x), o2 = bflo(ow.y), o3 = bfhi(ow.y), q0 = bflo(gw.x), q1 = bfhi(gw.x), q2 = bflo(gw.y), q3 = bfhi(gw.y);
                    u32x2 yw; yw.x = pk2(fmaf(o0, nr.x, nr.y) * q0, fmaf(o1, nr.x, nr.y) * q1);
                    yw.y = pk2(fmaf(o2, nr.x, nr.y) * q2, fmaf(o3, nr.x, nr.y) * q3);
                    *(LAS u32x2*)(owr + e4 * 32) = yw; } }
#pragma unroll
            for (int e4 = 0; e4 < 4; ++e4) { const f32x4 o = oacc[e4]; oprev[e4].x = pk2(o[0], o[1]); oprev[e4].y = pk2(o[2], o[3]); }
#pragma unroll
            for (int a = 0; a < 2; ++a)
#pragma unroll
                for (int e4 = 0; e4 < 4; ++e4) {
                    sto[a][e4] = sto[a][e4] * g64; stx[a][e4] = stx[a][e4] * g64;
                    u32x2 o; o.x = pk2(sto[a][e4][0], sto[a][e4][1]); o.y = pk2(sto[a][e4][2], sto[a][e4][3]); *(LAS u32x2*)(swo + e4 * 16 * RT_STS + a * 32) = o;
                    u32x2 x; x.x = pk2(stx[a][e4][0], stx[a][e4][1]); x.y = pk2(stx[a][e4][2], stx[a][e4][3]); *(LAS u32x2*)(swo + dsx + e4 * 16 * RT_STS + a * 32) = x; }
        }
        __syncthreads();
#pragma unroll
        for (int k = 0; k < 2; ++k) { const u32x4 ov = *(const LAS u32x4*)(ord_ + k * 32 * RT_VSS);
            if (DRY) *(u32x4*)(dry + ((size_t)b * SEQ + (SEQ - 64) + 32 * k + (tid >> 4)) * DM + (h * 4 + es) * 64 + (tid & 7) * 8) = ov;
            else __builtin_amdgcn_raw_buffer_store_b128(ov, rs, voff, gcol + (SEQ - 64 + 32 * k) * ROWB, 0); }
        __syncthreads();
    }
}

template <bool DRY> __device__ __forceinline__ void retfin_phase(bf16* U, bf16* dry, const float* stats, int G, int vcu, int tid) {
    const int lane = tid & 63, wave = __builtin_amdgcn_readfirstlane(tid >> 6);
    const int gw = vcu * NWAVES + wave, NGW = G * NWAVES;
    for (int it = gw; it < M * RH; it += NGW) {
        const int m = it >> 2, h = it & 3;
        const f32x4 sa = *(const f32x4*)(stats + (size_t)it * 8), sb = *(const f32x4*)(stats + (size_t)it * 8 + 4);
        const float s1 = (sa.x + sa.z) + (sb.x + sb.z), s2 = (sa.y + sa.w) + (sb.y + sb.w);
        const float mu = s1 * (1.0f / VH), var = fmaxf(s2 * (1.0f / VH) - mu * mu, 0.f), rstd = 1.0f / sqrtf(var + GN_EPS);
        bf16* rowp = U + (size_t)m * NRET;
        const u32x4 ov = *(const u32x4*)(rowp + 2 * QKD + h * VH + lane * 8);
        u32x4* gp = (u32x4*)(rowp + 2 * QKD + VD + h * VH + lane * 8);
        const u32x4 gv = *gp;
        const unsigned ow[4] = {ov.x, ov.y, ov.z, ov.w}, gw4[4] = {gv.x, gv.y, gv.z, gv.w}; unsigned yw[4];
#pragma unroll
        for (int j = 0; j < 4; ++j) { const float o0 = bflo(ow[j]), o1 = bfhi(ow[j]), g0 = bflo(gw4[j]), g1 = bfhi(gw4[j]);
            yw[j] = pk2((o0 - mu) * rstd * g0 * sigmoidf_fast(g0), (o1 - mu) * rstd * g1 * sigmoidf_fast(g1)); }
        if (DRY) *(u32x4*)(dry + (size_t)m * DM + (h & 1) * 512 + lane * 8) = (u32x4){yw[0], yw[1], yw[2], yw[3]};
        else *gp = (u32x4){yw[0], yw[1], yw[2], yw[3]};
    }
}

__device__ __forceinline__ KArgs pargs() { KArgs p = (KArgs)__builtin_amdgcn_kernarg_segment_ptr(); asm volatile("" : "+s"(p)); return p; }
__device__ __forceinline__ int ptid() { int t = threadIdx.x; asm volatile("" : "+v"(t)); return t; }
constexpr int N_PHASES = 17;
__global__ void __launch_bounds__(NWAVES * 64, 2) hybrid_fwd(Args args) {
    extern __shared__ __attribute__((aligned(16))) unsigned char lds_raw[];
    LAS unsigned char* lds = (LAS unsigned char*)lds_raw;
    const int tid = threadIdx.x, G = gridDim.x, bid = blockIdx.x;
    const int vcu = (G % 8 == 0) ? (bid % 8) * (G / 8) + bid / 8 : bid;
    unsigned* ctl = (unsigned*)(pargs()->ws + WS_CTL);
    for (int u = tid; u < (LDS_BYTES - LDSCTL_OFF) / 4; u += NWAVES * 64) ((LAS unsigned*)(lds + LDSCTL_OFF))[u] = 0u;
    __syncthreads();
    volatile LAS unsigned* MISC = (volatile LAS unsigned*)(lds + MISC_OFF);
    XcdBarrier bar; bar.bar = ctl + CW_BAR; bar.x = 0; bar.st = nullptr;
    if (!MK_SPLIT) bar = xcd_barrier_post(ctl + CW_BAR, MISC + 8);
    const int lo = pargs()->ph_lo, hi = pargs()->ph_hi;
#define IN(k) (lo <= (k) && (k) < hi)
#define SEAM(k) do { if (IN(k) && IN((k) + 1)) { if (MK_SPLIT) { if (tid == 0) __hip_atomic_store(ctl + 0, 0xBADBA0u, __ATOMIC_RELAXED, __HIP_MEMORY_SCOPE_AGENT); } else xcd_barrier(bar); } } while (0)


    if (IN(0) && EN(0)) { p0_prologue(lds, pargs(), G, vcu, ptid()); __syncthreads(); }
    SEAM(0);
#pragma unroll 1
    for (int lp = 0; lp < 2; ++lp) {
        const int pb = 1 + 8 * lp;
        if (IN(pb + 0) && EN(1)) {
            KArgs args = pargs(); unsigned char* ws = args->ws; bf16* H = (bf16*)(ws + WS_H); bf16* U = (bf16*)(ws + WS_U);
            pg8::Gemm g{H, (const bf16*)(ws + WS_WLIN) + (size_t)lp * NLRU * DM, M, NLRU, DM, DM}; pg8::StaticOrder S; S.init(M, NLRU, G, bid);
            pg8::EpiPlain E{U, NLRU, DRNN / 256};
            if (PROBE_DUP & 512) { pg8::EpiNull EN_; pg8::gemm_phase<pg8::EpiNull, pg8::StaticOrder, true, true>(lds, g, S, EN_, ptid()); }
            if (PROBE_DUP & (1 | 32)) pg8::gemm_phase<pg8::EpiPlain, pg8::StaticOrder, PGA, true>(lds, g, S, E, ptid());
            pg8::gemm_phase<pg8::EpiPlain, pg8::StaticOrder, PGA, true>(lds, g, S, E, ptid());
        }
        SEAM(pb + 0);
        if (IN(pb + 1) && EN(2)) {
            KArgs args = pargs(); unsigned char* ws = args->ws; bf16* H = (bf16*)(ws + WS_H); bf16* U = (bf16*)(ws + WS_U);
            const bf16* gwp = (const bf16*)(ws + WS_GATEW) + (size_t)lp * 2 * NGB * BW * BW;
            if (PROBE_DUP & 2) { lru_phase<true>(lds, U, H, gwp, args->in[4] + (size_t)lp * 4 * DRNN, args->in[5] + (size_t)lp * DRNN,
                      args->in[7] + (size_t)lp * DRNN, args->in[9] + (size_t)lp * DRNN, args->in[10] + (size_t)lp * DRNN, G, vcu, ptid()); __syncthreads(); }
            lru_phase<false>(lds, U, H, gwp, args->in[4] + (size_t)lp * 4 * DRNN, args->in[5] + (size_t)lp * DRNN,
                      args->in[7] + (size_t)lp * DRNN, args->in[9] + (size_t)lp * DRNN, args->in[10] + (size_t)lp * DRNN, G, vcu, ptid());
        }
        SEAM(pb + 1);
        if (IN(pb + 2) && EN(3)) {
            KArgs args = pargs(); unsigned char* ws = args->ws; bf16* H = (bf16*)(ws + WS_H); bf16* U = (bf16*)(ws + WS_U);
            pg8::Gemm g{U + DRNN, (const bf16*)(ws + WS_WLOUT) + (size_t)lp * DM * DRNN, M, DM, DRNN, NLRU}; pg8::StaticOrder S; S.init(M, DM, G, bid);
            pg8::EpiPlain E{U, NLRU, 1 << 30};
            if (PROBE_DUP & (1 | 64)) pg8::gemm_phase<pg8::EpiPlain, pg8::StaticOrder, PGA, true>(lds, g, S, E, ptid());
            pg8::gemm_phase<pg8::EpiPlain, pg8::StaticOrder, PGA, true>(lds, g, S, E, ptid());
        }
        SEAM(pb + 2);
        if (IN(pb + 3) && EN(4)) {
            KArgs args = pargs(); unsigned char* ws = args->ws; bf16* H = (bf16*)(ws + WS_H); bf16* U = (bf16*)(ws + WS_U); float* dryf = (float*)U; bf16* dryh = U + (size_t)M * DM * 2;
            const int layer = 2 * lp;
            norm_phase(H, (float*)(ws + WS_RMS), U, NLRU, args->in[2] + (size_t)layer * DM, args->out, false, G, vcu, ptid());
        }
        SEAM(pb + 3);
        if (IN(pb + 4) && EN(5)) {
            KArgs args = pargs(); unsigned char* ws = args->ws; bf16* H = (bf16*)(ws + WS_H); bf16* U = (bf16*)(ws + WS_U); const float* rcos = (const float*)(ws + WS_ROPE); const float* rsin = rcos + SEQ * 128;
            pg8::Gemm g{H, (const bf16*)(ws + WS_WRIN) + (size_t)lp * NRET * DM, M, NRET, DM, DM}; pg8::StaticOrder S; S.init(M, NRET, G, bid);
            pg8::EpiRet E{U, NRET, rcos, rsin};
            if (PROBE_DUP & (1 | 128)) pg8::gemm_phase<pg8::EpiRet, pg8::StaticOrder, PGA, true>(lds, g, S, E, ptid());
            pg8::gemm_phase<pg8::EpiRet, pg8::StaticOrder, PGA, true>(lds, g, S, E, ptid());
        }
        SEAM(pb + 4);
        if (IN(pb + 5) && EN(6)) {
            KArgs args = pargs(); unsigned char* ws = args->ws; bf16* H = (bf16*)(ws + WS_H); bf16* U = (bf16*)(ws + WS_U); float* stats = (float*)(ws + WS_STATS);
            if (PROBE_DUP & 4) { ret_phase<true>(lds, U, H, (unsigned long long*)(ws + WS_GRAN), lp, G, vcu, ptid()); __syncthreads(); }
            ret_phase<false>(lds, U, H, (unsigned long long*)(ws + WS_GRAN), lp, G, vcu, ptid());
        }
        SEAM(pb + 5);
        if (IN(pb + 6) && EN(8)) {
            KArgs args = pargs(); unsigned char* ws = args->ws; bf16* H = (bf16*)(ws + WS_H); bf16* U = (bf16*)(ws + WS_U);
            pg8::Gemm g{U + 2 * QKD + VD, (const bf16*)(ws + WS_WROUT) + (size_t)lp * DM * VD, M, DM, VD, NRET}; pg8::StaticOrder S; S.init(M, DM, G, bid);
            pg8::EpiPlain E{U, NRET, 1 << 30};
            if (PROBE_DUP & (1 | 256)) pg8::gemm_phase<pg8::EpiPlain, pg8::StaticOrder, PGA, true>(lds, g, S, E, ptid());
            pg8::gemm_phase<pg8::EpiPlain, pg8::StaticOrder, PGA, true>(lds, g, S, E, ptid());
        }
        SEAM(pb + 6);
        if (IN(pb + 7) && EN(4)) {
            KArgs args = pargs(); unsigned char* ws = args->ws; bf16* H = (bf16*)(ws + WS_H); bf16* U = (bf16*)(ws + WS_U); float* dryf = (float*)U; bf16* dryh = U + (size_t)M * DM * 2;
            const int layer = 2 * lp + 1;
            norm_phase(H, (float*)(ws + WS_RMS), U, NRET, args->in[2] + (size_t)layer * DM, args->out, lp == 1, G, vcu, ptid());
        }
        SEAM(pb + 7);
    }
#undef IN
#undef SEAM
}

extern "C" void kernel_launch(void* const* d_in, const int* in_sizes, int n_in, void* d_out, int out_size, void* d_ws, size_t ws_size, hipStream_t stream) {
    static int grid = 0;
    if (grid == 0) {
        if (n_in != 14 || in_sizes[0] != M * DM || out_size != M * DM || ws_size < WS_END) {
            fprintf(stderr, "kernel_launch: unexpected shapes (n_in %d, in0 %d, out %d, ws %zu); nothing launched\n", n_in, n_in > 0 ? in_sizes[0] : -1, out_size, ws_size); grid = -1; return; }
        int dev = 0, cus = 0, per_cu = 0;
        if (hipGetDevice(&dev) != hipSuccess || hipDeviceGetAttribute(&cus, hipDeviceAttributeMultiprocessorCount, dev) != hipSuccess) { fprintf(stderr, "kernel_launch: device query failed\n"); grid = -1; return; }
        if (hipFuncSetAttribute((const void*)hybrid_fwd, hipFuncAttributeMaxDynamicSharedMemorySize, LDS_BYTES) != hipSuccess) { fprintf(stderr, "kernel_launch: hipFuncSetAttribute failed\n"); grid = -1; return; }
        if (hipOccupancyMaxActiveBlocksPerMultiprocessor(&per_cu, (const void*)hybrid_fwd, NWAVES * 64, LDS_BYTES) != hipSuccess || per_cu < 1)
            fprintf(stderr, "kernel_launch: note: occupancy query reports %d workgroups per CU\n", per_cu);
        (void)hipGetLastError();
        grid = cus;
    }
    if (grid < 0) return;
    if (hipMemsetAsync((char*)d_ws + WS_CTL, 0, CTL_ZERO_BYTES, stream) != hipSuccess) { fprintf(stderr, "kernel_launch: memset failed\n"); return; }
    Args a{};
    for (int i = 0; i < 14; ++i) a.in[i] = (const float*)d_in[i];
    a.out = (float*)d_out; a.ws = (unsigned char*)d_ws;
#if MK_SPLIT
    for (int p = 0; p < N_PHASES; ++p) { a.ph_lo = p; a.ph_hi = p + 1; hipLaunchKernelGGL(hybrid_fwd, dim3(grid), dim3(NWAVES * 64), LDS_BYTES, stream, a); }
#else
    a.ph_lo = 0; a.ph_hi = N_PHASES;
    hipLaunchKernelGGL(hybrid_fwd, dim3(grid), dim3(NWAVES * 64), LDS_BYTES, stream, a);
#endif
    const hipError_t le = hipPeekAtLastError();
    if (le != hipSuccess) fprintf(stderr, "kernel_launch: launch failed: %s\n", hipGetErrorName(le));
}
```
